# Optimizing an MI355X kernel written in HIP

```python
import math
import jax, jax.numpy as jnp
from jax import lax
import numpy as np

D_MODEL = 2048
BATCH = 2
SEQ = 8192
DEPTH = 1

N_META = 16
BLOCK_Q = 128
LEAD_PAD = BLOCK_Q - N_META
RMS_EPS = 1e-6
NEG_INF = -1e30

DA_HEADS = 8
DA_HEAD_DIM = 64
DA_V_DIM = 2 * DA_HEAD_DIM
DA_LAMBDA_DIM = DA_HEAD_DIM

MLA_HEADS = 8
MLA_Q_RANK = 768
MLA_KV_RANK = 512
MLA_NOPE_DIM = 128
MLA_ROPE_DIM = 64
MLA_V_DIM = 128
ROPE_THETA = 10000.0

REL_BUCKETS = 32
REL_MAX_DIST = 128

D_FF = 5632

N_BRANCH = 2
DA_QK_W = DA_HEADS * 2 * DA_HEAD_DIM
DA_V_W = DA_HEADS * DA_V_DIM
MLA_OUT_W = MLA_HEADS * MLA_V_DIM
COL_SPLITS = (DA_QK_W, DA_QK_W, DA_V_W, MLA_Q_RANK, MLA_KV_RANK, MLA_ROPE_DIM, N_BRANCH * D_MODEL)
IN_PROJ_W = sum(COL_SPLITS)

kernel_name = "hybrid_diffattn_mla_gated_macaron"


def rmsnorm(x, g):
    xf = x.astype(jnp.float32)
    y = xf * lax.rsqrt(jnp.mean(xf * xf, axis=-1, keepdims=True) + RMS_EPS)
    return (y * g.astype(jnp.float32)).astype(x.dtype)


def swiglu(x, w_gate, w_up, w_down):
    return (jax.nn.silu(x @ w_gate) * (x @ w_up)) @ w_down


def rope(x, pos):
    half = x.shape[-1] // 2
    inv = ROPE_THETA ** (-jnp.arange(half, dtype=jnp.float32) * 2.0 / x.shape[-1])
    ang = pos.astype(jnp.float32)[:, None] * inv[None, :]
    ang = ang.reshape((1, pos.shape[0]) + (1,) * (x.ndim - 3) + (half,))
    cos, sin = jnp.cos(ang), jnp.sin(ang)
    xf = x.astype(jnp.float32)
    x1, x2 = xf[..., :half], xf[..., half:]
    return jnp.concatenate([x1 * cos - x2 * sin, x1 * sin + x2 * cos], axis=-1).astype(x.dtype)


def t5_causal_bucket(rel):
    n = jnp.maximum(rel, 0)
    max_exact = REL_BUCKETS // 2
    n_f = jnp.maximum(n, 1).astype(jnp.float32)
    large = max_exact + (jnp.log(n_f / max_exact) / math.log(REL_MAX_DIST / max_exact)
                         * (REL_BUCKETS - max_exact)).astype(jnp.int32)
    large = jnp.minimum(large, REL_BUCKETS - 1)
    return jnp.where(n < max_exact, n, large)


def causal_mask(q_pos, k_pos):
    kp = k_pos[None, :]
    qp = q_pos[:, None]
    return (kp <= qp) & ((kp >= LEAD_PAD) | (kp == qp))


def diff_attention(q, k, v, lam, lambda_init, sub_g, rel_bias_table):
    B, Lp, _ = q.shape
    n_blk = Lp // BLOCK_Q
    q = q.reshape(B, n_blk, BLOCK_Q, DA_HEADS, 2, DA_HEAD_DIM).transpose(1, 0, 3, 4, 2, 5)
    k = k.reshape(B, Lp, DA_HEADS, 2, DA_HEAD_DIM).transpose(0, 2, 3, 1, 4)
    v = v.reshape(B, Lp, DA_HEADS, DA_V_DIM).transpose(0, 2, 1, 3)
    k_pos = jnp.arange(Lp)
    scale = DA_HEAD_DIM ** -0.5
    table = rel_bias_table.astype(jnp.float32)

    def block(args):
        q_blk, b = args
        q_pos = b * BLOCK_Q + jnp.arange(BLOCK_Q)
        s = jnp.einsum("bhcqd,bhckd->bhcqk", q_blk, k, preferred_element_type=jnp.float32) * scale
        bias = table[t5_causal_bucket(q_pos[:, None] - k_pos[None, :])]
        s = s + jnp.transpose(bias, (2, 0, 1))[None, :, None]
        s = jnp.where(causal_mask(q_pos, k_pos), s, NEG_INF)
        p = jax.nn.softmax(s, axis=-1)
        a = p[:, :, 0] - lam * p[:, :, 1]
        return jnp.einsum("bhqk,bhkv->bhqv", a.astype(v.dtype), v)

    o = lax.map(block, (q, jnp.arange(n_blk)))
    o = o.transpose(1, 0, 3, 2, 4).reshape(B, Lp, DA_HEADS, DA_V_DIM)
    o = rmsnorm(o, sub_g) * (1.0 - lambda_init)
    return o.reshape(B, Lp, DA_V_W)


def mla_attention(c_q, c_kv, k_rope_in, q_norm_g, kv_norm_g, w_uq, w_ukv, pos):
    B, Lp, _ = c_q.shape
    n_blk = Lp // BLOCK_Q
    q = (rmsnorm(c_q, q_norm_g) @ w_uq).reshape(B, Lp, MLA_HEADS, MLA_NOPE_DIM + MLA_ROPE_DIM)
    q_nope = q[..., :MLA_NOPE_DIM]
    q_rope = rope(q[..., MLA_NOPE_DIM:], pos)
    kv = (rmsnorm(c_kv, kv_norm_g) @ w_ukv).reshape(B, Lp, MLA_HEADS, MLA_NOPE_DIM + MLA_V_DIM)
    k_nope, v = kv[..., :MLA_NOPE_DIM], kv[..., MLA_NOPE_DIM:]
    k_rope = rope(k_rope_in, pos)
    k_pos = jnp.arange(Lp)
    scale = (MLA_NOPE_DIM + MLA_ROPE_DIM) ** -0.5

    def to_blocks(t):
        return t.reshape((B, n_blk, BLOCK_Q) + t.shape[2:]).swapaxes(0, 1)

    def block(args):
        qn, qr, b = args
        q_pos = b * BLOCK_Q + jnp.arange(BLOCK_Q)
        s = (jnp.einsum("bqhd,bkhd->bhqk", qn, k_nope, preferred_element_type=jnp.float32)
             + jnp.einsum("bqhr,bkr->bhqk", qr, k_rope, preferred_element_type=jnp.float32)) * scale
        s = jnp.where(causal_mask(q_pos, k_pos), s, NEG_INF)
        p = jax.nn.softmax(s, axis=-1)
        return jnp.einsum("bhqk,bkhv->bqhv", p.astype(v.dtype), v)

    o = lax.map(block, (to_blocks(q_nope), to_blocks(q_rope), jnp.arange(n_blk)))
    return o.swapaxes(0, 1).reshape(B, Lp, MLA_OUT_W)


def setup_inputs(seed: int = 0) -> dict:
    key = jax.random.key(seed)
    ks = iter(jax.random.split(key, 40))
    f32 = jnp.float32

    def w(shape, fan_in):
        return jax.random.normal(next(ks), shape, f32) * (fan_in ** -0.5)

    def gain(shape):
        return 1.0 + 0.1 * jax.random.normal(next(ks), shape, f32)

    L = DEPTH
    return {
        "x": jax.random.normal(next(ks), (BATCH, SEQ, D_MODEL), f32),
        "meta_tokens": jax.random.normal(next(ks), (N_META, D_MODEL), f32),
        "rel_bias_table": 0.3 * jax.random.normal(next(ks), (REL_BUCKETS, DA_HEADS), f32),
        "ffn1_pre_g": gain((L, D_MODEL)),
        "ffn1_post_g": gain((L, D_MODEL)),
        "ffn1_w_gate": w((L, D_MODEL, D_FF), D_MODEL),
        "ffn1_w_up": w((L, D_MODEL, D_FF), D_MODEL),
        "ffn1_w_down": w((L, D_FF, D_MODEL), D_FF),
        "mix_pre_g": gain((L, D_MODEL)),
        "mix_post_g": gain((L, D_MODEL)),
        "w_in": w((L, D_MODEL, IN_PROJ_W), D_MODEL),
        "b_gate": 0.1 * jax.random.normal(next(ks), (L, N_BRANCH * D_MODEL), f32),
        "da_lambda_q1": 0.1 * jax.random.normal(next(ks), (L, DA_LAMBDA_DIM), f32),
        "da_lambda_k1": 0.1 * jax.random.normal(next(ks), (L, DA_LAMBDA_DIM), f32),
        "da_lambda_q2": 0.1 * jax.random.normal(next(ks), (L, DA_LAMBDA_DIM), f32),
        "da_lambda_k2": 0.1 * jax.random.normal(next(ks), (L, DA_LAMBDA_DIM), f32),
        "da_sub_g": gain((L, DA_V_DIM)),
        "mla_q_norm_g": gain((L, MLA_Q_RANK)),
        "mla_kv_norm_g": gain((L, MLA_KV_RANK)),
        "mla_w_uq": w((L, MLA_Q_RANK, MLA_HEADS * (MLA_NOPE_DIM + MLA_ROPE_DIM)), MLA_Q_RANK),
        "mla_w_ukv": w((L, MLA_KV_RANK, MLA_HEADS * (MLA_NOPE_DIM + MLA_V_DIM)), MLA_KV_RANK),
        "w_branch_da": w((L, DA_V_W, D_MODEL), DA_V_W),
        "w_branch_mla": w((L, MLA_OUT_W, D_MODEL), MLA_OUT_W),
        "w_out": w((L, D_MODEL, D_MODEL), D_MODEL),
        "ffn2_pre_g": gain((L, D_MODEL)),
        "ffn2_post_g": gain((L, D_MODEL)),
        "ffn2_w_gate": w((L, D_MODEL, D_FF), D_MODEL),
        "ffn2_w_up": w((L, D_MODEL, D_FF), D_MODEL),
        "ffn2_w_down": w((L, D_FF, D_MODEL), D_FF),
    }


def reference(x, meta_tokens, rel_bias_table,
              ffn1_pre_g, ffn1_post_g, ffn1_w_gate, ffn1_w_up, ffn1_w_down,
              mix_pre_g, mix_post_g, w_in, b_gate,
              da_lambda_q1, da_lambda_k1, da_lambda_q2, da_lambda_k2, da_sub_g,
              mla_q_norm_g, mla_kv_norm_g, mla_w_uq, mla_w_ukv,
              w_branch_da, w_branch_mla, w_out,
              ffn2_pre_g, ffn2_post_g, ffn2_w_gate, ffn2_w_up, ffn2_w_down):
    B = x.shape[0]
    pad = jnp.zeros((B, LEAD_PAD, D_MODEL), x.dtype)
    meta = jnp.broadcast_to(meta_tokens.astype(x.dtype)[None], (B, N_META, D_MODEL))
    h = jnp.concatenate([pad, meta, x], axis=1)
    Lp = h.shape[1]
    pos = jnp.arange(Lp) - LEAD_PAD
    offs = np.cumsum(np.array(COL_SPLITS))[:-1].tolist()

    for l in range(DEPTH):
        f = swiglu(rmsnorm(h, ffn1_pre_g[l]), ffn1_w_gate[l], ffn1_w_up[l], ffn1_w_down[l])
        h = h + 0.5 * rmsnorm(f, ffn1_post_g[l])

        hn = rmsnorm(h, mix_pre_g[l])
        proj = hn @ w_in[l]
        da_q, da_k, da_v, mla_cq, mla_ckv, mla_kr, gate_logits = jnp.split(proj, offs, axis=-1)

        lambda_init = 0.8 - 0.6 * math.exp(-0.3 * l)
        lam = (jnp.exp(jnp.sum(da_lambda_q1[l].astype(jnp.float32) * da_lambda_k1[l].astype(jnp.float32)))
               - jnp.exp(jnp.sum(da_lambda_q2[l].astype(jnp.float32) * da_lambda_k2[l].astype(jnp.float32)))
               + lambda_init)
        y_da = diff_attention(da_q, da_k, da_v, lam, lambda_init, da_sub_g[l], rel_bias_table)
        y_mla = mla_attention(mla_cq, mla_ckv, mla_kr, mla_q_norm_g[l], mla_kv_norm_g[l],
                              mla_w_uq[l], mla_w_ukv[l], pos)

        gates = jax.nn.sigmoid((gate_logits + b_gate[l]).astype(jnp.float32)).reshape(B, Lp, N_BRANCH, D_MODEL)
        merged = (gates[:, :, 0] * (y_da @ w_branch_da[l]).astype(jnp.float32)
                  + gates[:, :, 1] * (y_mla @ w_branch_mla[l]).astype(jnp.float32)).astype(h.dtype)
        m = merged @ w_out[l]
        h = h + rmsnorm(m, mix_post_g[l])

        f = swiglu(rmsnorm(h, ffn2_pre_g[l]), ffn2_w_gate[l], ffn2_w_up[l], ffn2_w_down[l])
        h = h + 0.5 * rmsnorm(f, ffn2_post_g[l])

    return h[:, LEAD_PAD + N_META:]
```

```cpp
#include <hip/hip_runtime.h>
#include <hip/hip_cooperative_groups.h>
#include <cstdio>
#include <cstdint>
namespace cg = cooperative_groups;

constexpr int D = 2048, NBATCH = 2, SEQ = 8192, MROWS = NBATCH * SEQ, FF = 5632;
constexpr int NIN = 8704;
constexpr float RMS_EPS = 1e-6f;
constexpr float LOG2E = 1.4426950408889634f;

constexpr size_t OFF_CTL = 0, OFF_RSQ = 65536, OFF_RSKV = 131072, OFF_KR = 262144;
constexpr size_t OFF_M_HN = 2621440, OFF_M_ACT = 2686976, OFF_M_F = 2867200, OFF_M_C = 2998272, OFF_M_HN2 = 3041536;
constexpr size_t OFF_M_DAQKV = 3145728, OFF_M_KVMLA = 3538944, OFF_M_KR = 3801088, OFF_M_END = 3809280;
constexpr size_t OFF_WIN = 8388608, OFF_WUQ = 44040192, OFF_WUKV = 46399488, OFF_WBDA = 48496640, OFF_WBMLA = 52690944, OFF_WOUT = 56885248;
constexpr size_t OFF_FFN = 65273856, OFF_WD = 111411200;
constexpr size_t OFF_HN = 134479872, OFF_F = 201588736, OFF_BIG = 335806464, WS_NEED = 530841600;
constexpr size_t OFF_CBUF = OFF_BIG + 100663296, OFF_QMLA = OFF_CBUF + 44040192;
constexpr int CP = 1344;

namespace pg8 {
#define PG8_LAS __attribute__((address_space(3)))
typedef unsigned short bf16_t;
typedef short bf16x8 __attribute__((ext_vector_type(8)));
typedef float f32x4 __attribute__((ext_vector_type(4)));
typedef unsigned u32x4 __attribute__((ext_vector_type(4)));
constexpr int BM = 256, BK = 64, HALF = 128, HTB = HALF * BK * 2  , STAGE_BYTES = 8 * HTB, NXCD = 8, WGM = 8;

__host__ __device__ __forceinline__ int lds_byte(int r, int c) { const int st = (r >> 4) * 2 + (c >> 5), rr = r & 15, cc = c & 31, ob = rr * 64 + cc * 2; return st * 1024 + (ob ^ (((ob >> 9) & 1) << 5)); }
__host__ __device__ __forceinline__ void stage_rc(int b, int& R, int& C) { const int st = b / 1024, sb = b % 1024, swz = sb ^ (((sb >> 9) & 1) << 5); R = (st >> 1) * 16 + swz / 64; C = (st & 1) * 32 + (swz % 64) / 2; }
__host__ __device__ __forceinline__ int perm32(int rho) { const int n = rho >> 4, i = rho & 15; return 8 * (i >> 2) + 4 * n + (i & 3); }

struct Unit { int pm, pn; };
struct Gemm { const bf16_t* A; const bf16_t* Bt; int M, N, K, lda, ldb; };

struct StaticOrder {
    int nM, nN, nwg, G, c;
    __host__ __device__ void init(int M, int N, int G_, int c_) { nM = M / BM; nN = N / BM; nwg = nM * nN; G = G_; c = c_; }
    __host__ __device__ bool next(int i, Unit& u) const {
        const long L = (long)i * G + c; if (L >= nwg) return false;
        int wgid = (int)L; { const int q = nwg / NXCD, r = nwg % NXCD, xcd = wgid % NXCD, off = wgid / NXCD; wgid = (xcd < r ? xcd * (q + 1) : r * (q + 1) + (xcd - r) * q) + off; }
        const int nig = WGM * nN, gid = wgid / nig, fm = gid * WGM, gsz = (nM - fm) < WGM ? (nM - fm) : WGM;
        u.pm = fm + ((wgid % nig) % gsz); u.pn = (wgid % nig) / gsz; return true;
    }
    __device__ __forceinline__ void a_ready(const Unit&) const {}
    __device__ __forceinline__ void done(const Unit&) const {}
};

__device__ __forceinline__ unsigned cvt_pk_bf16(float lo, float hi) { unsigned r; asm volatile("v_cvt_pk_bf16_f32 %0, %1, %2" : "=v"(r) : "v"(lo), "v"(hi)); return r; }
__device__ __forceinline__ float bf_lo(unsigned w) { return __uint_as_float(w << 16); }
__device__ __forceinline__ float bf_hi(unsigned w) { return __uint_as_float(w & 0xffff0000u); }
__device__ __forceinline__ float sigmoidf_(float x) { return __builtin_amdgcn_rcpf(1.f + __expf(-x)); }
typedef unsigned u32x2 __attribute__((ext_vector_type(2)));

struct EpiAct {
    static constexpr bool PERM = true, AFTER_DRAIN = false;
    bf16_t* O;
    __device__ __forceinline__ void operator()(const f32x4 (&acc)[2][2][4][2], const Unit& u, int wr, int wc, int fr, int fq) const {
        const int row0 = u.pm * BM + wr * 64 + fr, col0 = u.pn * 128 + wc * 32 + 8 * fq;
#pragma unroll
        for (int ai = 0; ai < 2; ++ai)
#pragma unroll
            for (int m = 0; m < 4; ++m) {
                float v[8];
#pragma unroll
                for (int n = 0; n < 2; ++n)
#pragma unroll
                    for (int j = 0; j < 4; ++j) { const float g = acc[ai][0][m][n][j], up = acc[ai][1][m][n][j]; v[n * 4 + j] = g * sigmoidf_(g) * up; }
                u32x4 w; w.x = cvt_pk_bf16(v[0], v[1]); w.y = cvt_pk_bf16(v[2], v[3]); w.z = cvt_pk_bf16(v[4], v[5]); w.w = cvt_pk_bf16(v[6], v[7]);
                *(u32x4*)(O + (size_t)(row0 + ai * HALF + m * 16) * FF + col0) = w;
            }
    }
};
struct EpiBf16 {
    static constexpr bool PERM = true, AFTER_DRAIN = false;
    bf16_t* O; int ldc;
    __device__ __forceinline__ void operator()(const f32x4 (&acc)[2][2][4][2], const Unit& u, int wr, int wc, int fr, int fq) const {
        const int row0 = u.pm * BM + wr * 64 + fr, col0 = u.pn * BM + wc * 32 + 8 * fq;
#pragma unroll
        for (int ai = 0; ai < 2; ++ai)
#pragma unroll
            for (int m = 0; m < 4; ++m) { bf16_t* rowp = O + (size_t)(row0 + ai * HALF + m * 16) * ldc + col0;
#pragma unroll
                for (int bj = 0; bj < 2; ++bj) { const f32x4 v0 = acc[ai][bj][m][0], v1 = acc[ai][bj][m][1];
                    u32x4 w; w.x = cvt_pk_bf16(v0[0], v0[1]); w.y = cvt_pk_bf16(v0[2], v0[3]); w.z = cvt_pk_bf16(v1[0], v1[1]); w.w = cvt_pk_bf16(v1[2], v1[3]);
                    *(u32x4*)(rowp + bj * HALF) = w; } }
    }
};
struct EpiF32 {
    static constexpr bool PERM = false, AFTER_DRAIN = false;
    float* O; int ldc;
    __device__ __forceinline__ void operator()(const f32x4 (&acc)[2][2][4][2], const Unit& u, int wr, int wc, int fr, int fq) const {
        const int row0 = u.pm * BM + wr * 64 + fr, col0 = u.pn * BM + wc * 32 + 4 * fq;
#pragma unroll
        for (int ai = 0; ai < 2; ++ai)
#pragma unroll
            for (int m = 0; m < 4; ++m) { float* rowp = O + (size_t)(row0 + ai * HALF + m * 16) * ldc + col0;
#pragma unroll
                for (int bj = 0; bj < 2; ++bj)
#pragma unroll
                    for (int n = 0; n < 2; ++n) *(f32x4*)(rowp + bj * HALF + n * 16) = acc[ai][bj][m][n]; }
    }
};
struct EpiInProj {
    static constexpr bool PERM = true, AFTER_DRAIN = false;
    bf16_t* gates; bf16_t* daqkv; bf16_t* cbuf; const float* bgate; float* rsq; float* rskv;
    __device__ __forceinline__ void operator()(const f32x4 (&acc)[2][2][4][2], const Unit& u, int wr, int wc, int fr, int fq) const {
        const int row0 = u.pm * BM + wr * 64 + fr, lc0 = wc * 32 + 8 * fq;
        const int pn = u.pn;
        {
            bf16_t* base; int ldc, cb; float* rs = nullptr;
            if (pn < 16) { base = gates; ldc = 4096; cb = pn * BM; }
            else if (pn < 28) { base = daqkv; ldc = 3072; cb = (pn - 16) * BM; }
            else { base = cbuf; ldc = CP; cb = (pn - 28) * BM; if (pn < 31) rs = rsq; else if (pn < 33) rs = rskv; }
            const bool last = (pn == 33);
#pragma unroll
            for (int ai = 0; ai < 2; ++ai)
#pragma unroll
                for (int m = 0; m < 4; ++m) { const int row = row0 + ai * HALF + m * 16; bf16_t* rowp = base + (size_t)row * ldc + cb + lc0; float ss = 0.f;
#pragma unroll
                    for (int bj = 0; bj < 2; ++bj) { const f32x4 v0 = acc[ai][bj][m][0], v1 = acc[ai][bj][m][1];
                        ss += (v0[0] * v0[0] + v0[1] * v0[1]) + (v0[2] * v0[2] + v0[3] * v0[3]) + (v1[0] * v1[0] + v1[1] * v1[1]) + (v1[2] * v1[2] + v1[3] * v1[3]);
                        u32x4 w; w.x = cvt_pk_bf16(v0[0], v0[1]); w.y = cvt_pk_bf16(v0[2], v0[3]); w.z = cvt_pk_bf16(v1[0], v1[1]); w.w = cvt_pk_bf16(v1[2], v1[3]);
                        if (!last || (bj == 0 && lc0 < 64)) *(u32x4*)(rowp + bj * HALF) = w; }
                    if (rs) { ss += __shfl_xor(ss, 16); ss += __shfl_xor(ss, 32); if (fq == 0) atomicAdd(rs + row, ss); } }
        }
    }
};
struct EpiRowScale {
    static constexpr bool PERM = true, AFTER_DRAIN = false;
    bf16_t* O; int ldc; const float* rs; float invk;
    __device__ __forceinline__ void operator()(const f32x4 (&acc)[2][2][4][2], const Unit& u, int wr, int wc, int fr, int fq) const {
        const int row0 = u.pm * BM + wr * 64 + fr, col0 = u.pn * BM + wc * 32 + 8 * fq;
#pragma unroll
        for (int ai = 0; ai < 2; ++ai)
#pragma unroll
            for (int m = 0; m < 4; ++m) { const int row = row0 + ai * HALF + m * 16; const float sc = __builtin_amdgcn_rsqf(__hip_atomic_load(rs + row, __ATOMIC_RELAXED, __HIP_MEMORY_SCOPE_AGENT) * invk + RMS_EPS); bf16_t* rowp = O + (size_t)row * ldc + col0;
#pragma unroll
                for (int bj = 0; bj < 2; ++bj) { const f32x4 v0 = acc[ai][bj][m][0] * sc, v1 = acc[ai][bj][m][1] * sc;
                    u32x4 w; w.x = cvt_pk_bf16(v0[0], v0[1]); w.y = cvt_pk_bf16(v0[2], v0[3]); w.z = cvt_pk_bf16(v1[0], v1[1]); w.w = cvt_pk_bf16(v1[2], v1[3]);
                    *(u32x4*)(rowp + bj * HALF) = w; } }
    }
};
template <int PASS> struct EpiGate {
    static constexpr bool PERM = false, AFTER_DRAIN = false;
    const bf16_t* gates; bf16_t* tmp; bf16_t* merged; const float* bgate;
    __device__ __forceinline__ void operator()(const f32x4 (&acc)[2][2][4][2], const Unit& u, int wr, int wc, int fr, int fq) const {
        const int row0 = u.pm * BM + wr * 64 + fr, col0 = u.pn * BM + wc * 32 + 4 * fq;
#pragma unroll
        for (int ai = 0; ai < 2; ++ai)
#pragma unroll
            for (int m = 0; m < 4; ++m) { const size_t row = (size_t)(row0 + ai * HALF + m * 16);
#pragma unroll
                for (int bj = 0; bj < 2; ++bj)
#pragma unroll
                    for (int n = 0; n < 2; ++n) { const int col = col0 + bj * HALF + n * 16;
                        const u32x2 gw = __builtin_nontemporal_load((const u32x2*)(gates + row * 4096 + PASS * 2048 + col));
                        const f32x4 bb = *(const f32x4*)(bgate + PASS * 2048 + col);
                        f32x4 g; g[0] = sigmoidf_(bf_lo(gw.x) + bb[0]); g[1] = sigmoidf_(bf_hi(gw.x) + bb[1]); g[2] = sigmoidf_(bf_lo(gw.y) + bb[2]); g[3] = sigmoidf_(bf_hi(gw.y) + bb[3]);
                        f32x4 v = acc[ai][bj][m][n] * g;
                        if (PASS == 0) { u32x2 w; w.x = cvt_pk_bf16(v[0], v[1]); w.y = cvt_pk_bf16(v[2], v[3]); *(u32x2*)(tmp + row * D + col) = w; }
                        else { const u32x2 tw = *(const u32x2*)(tmp + row * D + col); v = v + (f32x4){bf_lo(tw.x), bf_hi(tw.x), bf_lo(tw.y), bf_hi(tw.y)};
 u32x2 w; w.x = cvt_pk_bf16(v[0], v[1]); w.y = cvt_pk_bf16(v[2], v[3]); *(u32x2*)(merged + row * D + col) = w; } } }
    }
};

template <class Epi, class Sched, bool ALIGN_EPI = false, bool SP2 = false>
__device__ __forceinline__ void gemm_phase(PG8_LAS unsigned char* lds, const Gemm g, const Sched& S, const Epi& E) {
    const int tid = threadIdx.x, wid = __builtin_amdgcn_readfirstlane(tid >> 6), lane = tid & 63, wr = wid >> 2, wc = wid & 3, fr = lane & 15, fq = lane >> 4;
    const int K = g.K, nt = K / BK;
    unsigned voffA[2], voffB[2];
#pragma unroll
    for (int i = 0; i < 2; ++i) { int R, C; stage_rc(tid * 16 + i * 8192, R, C); const int Rb = Epi::PERM ? ((R & ~31) + perm32(R & 31)) : R;
        voffA[i] = (unsigned)(R * g.lda + C) * 2u; voffB[i] = (unsigned)(Rb * g.ldb + C) * 2u; }
    const size_t kstep = (size_t)(BK * 2);
    const size_t hstepA = (size_t)HALF * g.lda * 2, hstepB = (size_t)HALF * g.ldb * 2;
    const size_t tstepA = 2 * hstepA, tstepB = 2 * hstepB;
    const unsigned ldsw = (unsigned)wid * 1024u;
    const int aoff = lds_byte(wr * 64 + fr, fq * 8), boff = lds_byte(wc * 32 + fr, fq * 8);
#define PG8_SA(b, h) (((b) * 2 + (h)) * HTB)
#define PG8_SB(b, h) ((4 + (b) * 2 + (h)) * HTB)
#define PG8_STAGE(bufoff, gbase, voff) do { _Pragma("unroll") for (int _i = 0; _i < 2; ++_i) \
        __builtin_amdgcn_global_load_lds((const unsigned*)((const char*)(gbase) + (voff)[_i]), (PG8_LAS unsigned*)(lds + (bufoff) + ldsw + _i * 8192), 16, 0, 0); } while (0)
#define PG8_LDA(dst, b, h) do { _Pragma("unroll") for (int m = 0; m < 4; ++m) _Pragma("unroll") for (int k = 0; k < 2; ++k) dst[m][k] = *(const PG8_LAS bf16x8*)(lds + PG8_SA(b, h) + aoff + m * 2048 + k * 1024); } while (0)
#define PG8_LDB(dst, b, h) do { _Pragma("unroll") for (int n = 0; n < 2; ++n) _Pragma("unroll") for (int k = 0; k < 2; ++k) dst[n][k] = *(const PG8_LAS bf16x8*)(lds + PG8_SB(b, h) + boff + n * 2048 + k * 1024); } while (0)
#define PG8_MMA(ai, bj, At, Bt) do { __builtin_amdgcn_s_setprio(1); _Pragma("unroll") for (int m = 0; m < 4; ++m) _Pragma("unroll") for (int n = 0; n < 2; ++n) _Pragma("unroll") for (int k = 0; k < 2; ++k) \
        acc[ai][bj][m][n] = __builtin_amdgcn_mfma_f32_16x16x32_bf16(Bt[n][k], At[m][k], acc[ai][bj][m][n], 0, 0, 0); __builtin_amdgcn_s_setprio(0); } while (0)
#define PG8_WAIT_V(n) asm volatile("s_waitcnt vmcnt(" #n ")" ::: "memory")
#define PG8_WAIT_L(n) asm volatile("s_waitcnt lgkmcnt(" #n ")" ::: "memory")
#define PG8_BAR __builtin_amdgcn_s_barrier()
#define PG8_SCHED __builtin_amdgcn_sched_barrier(0)
    Unit cur, nxt; int ui = 0;
    if (!S.next(0, cur)) return;
    f32x4 acc[2][2][4][2];
#pragma unroll
    for (int a = 0; a < 2; ++a)
#pragma unroll
        for (int b = 0; b < 2; ++b)
#pragma unroll
            for (int m = 0; m < 4; ++m)
#pragma unroll
                for (int n = 0; n < 2; ++n) acc[a][b][m][n] = (f32x4){0.f, 0.f, 0.f, 0.f};
    bf16x8 At[4][2], B0[2][2], B1[2][2];
    const char* cA = (const char*)g.A + (size_t)cur.pm * tstepA; const char* cB = (const char*)g.Bt + (size_t)cur.pn * tstepB;
    S.a_ready(cur);
    if constexpr (SP2) {
        PG8_STAGE(PG8_SB(0, 0), cB, voffB); PG8_STAGE(PG8_SB(0, 1), cB + hstepB, voffB); PG8_STAGE(PG8_SA(0, 0), cA, voffA); PG8_STAGE(PG8_SA(0, 1), cA + hstepA, voffA);
        if (wr == 1) PG8_BAR;
        PG8_WAIT_V(2); PG8_BAR;
        PG8_STAGE(PG8_SB(1, 0), cB + kstep, voffB); PG8_STAGE(PG8_SA(1, 0), cA + kstep, voffA); PG8_STAGE(PG8_SB(1, 1), cB + hstepB + kstep, voffB);
        PG8_WAIT_V(6); PG8_BAR;
    } else {
        PG8_STAGE(PG8_SB(0, 0), cB, voffB); PG8_STAGE(PG8_SA(0, 0), cA, voffA); PG8_STAGE(PG8_SB(0, 1), cB + hstepB, voffB); PG8_STAGE(PG8_SA(0, 1), cA + hstepA, voffA);
        if (wr == 1) PG8_BAR;
        PG8_WAIT_V(4); PG8_BAR;
        PG8_STAGE(PG8_SB(1, 0), cB + kstep, voffB); PG8_STAGE(PG8_SA(1, 0), cA + kstep, voffA); PG8_STAGE(PG8_SB(1, 1), cB + hstepB + kstep, voffB);
        PG8_WAIT_V(6); PG8_BAR;
    }
    for (;;) {
        const bool has_next = S.next(ui + 1, nxt);
        const char* nA = has_next ? (const char*)g.A + (size_t)nxt.pm * tstepA : cA; const char* nB = has_next ? (const char*)g.Bt + (size_t)nxt.pn * tstepB : cB;
        for (int t = 0; t < nt; t += 2) {
            const bool last = (t == nt - 2);
            const char* a1 = cA + (size_t)(t + 1) * kstep;
            const char* a2 = last ? nA : cA + (size_t)(t + 2) * kstep; const char* b2 = last ? nB : cB + (size_t)(t + 2) * kstep;
            const char* a3 = a2 + kstep; const char* b3 = b2 + kstep;
            if (last && has_next) S.a_ready(nxt);
            if constexpr (SP2) {
            PG8_LDB(B0, 0, 0); PG8_LDB(B1, 0, 1); PG8_SCHED; PG8_LDA(At, 0, 0); PG8_STAGE(PG8_SA(1, 1), a1 + hstepA, voffA);
            PG8_WAIT_V(8); PG8_WAIT_L(0); PG8_BAR; PG8_MMA(0, 0, At, B0); PG8_MMA(0, 1, At, B1); PG8_BAR; PG8_SCHED;
            PG8_LDA(At, 0, 1); PG8_STAGE(PG8_SB(0, 0), b2, voffB); PG8_STAGE(PG8_SB(0, 1), b2 + hstepB, voffB); PG8_STAGE(PG8_SA(0, 0), a2, voffA);
            PG8_WAIT_V(8); PG8_WAIT_L(0); PG8_BAR; PG8_MMA(1, 0, At, B0); PG8_MMA(1, 1, At, B1); PG8_BAR; PG8_SCHED;
            PG8_LDB(B0, 1, 0); PG8_LDB(B1, 1, 1); PG8_SCHED; PG8_LDA(At, 1, 0); PG8_STAGE(PG8_SA(0, 1), a2 + hstepA, voffA);
            PG8_WAIT_V(8); PG8_WAIT_L(0); PG8_BAR; PG8_MMA(0, 0, At, B0); PG8_MMA(0, 1, At, B1); PG8_BAR; PG8_SCHED;
            PG8_LDA(At, 1, 1); PG8_STAGE(PG8_SB(1, 0), b3, voffB); PG8_STAGE(PG8_SB(1, 1), b3 + hstepB, voffB); PG8_STAGE(PG8_SA(1, 0), a3, voffA);
            PG8_WAIT_V(8); PG8_WAIT_L(0); PG8_BAR; PG8_MMA(1, 0, At, B0); PG8_MMA(1, 1, At, B1); PG8_BAR; PG8_SCHED;
            } else {
            PG8_LDB(B0, 0, 0); PG8_SCHED; PG8_LDA(At, 0, 0); PG8_STAGE(PG8_SA(1, 1), a1 + hstepA, voffA);
            PG8_WAIT_L(8); PG8_BAR; PG8_WAIT_L(0); PG8_MMA(0, 0, At, B0); PG8_BAR; PG8_SCHED;
            PG8_LDB(B1, 0, 1); PG8_STAGE(PG8_SB(0, 0), b2, voffB);
            PG8_BAR; PG8_WAIT_L(0); PG8_MMA(0, 1, At, B1); PG8_BAR;
            PG8_LDA(At, 0, 1); PG8_STAGE(PG8_SA(0, 0), a2, voffA);
            PG8_BAR; PG8_WAIT_L(0); PG8_MMA(1, 0, At, B0); PG8_BAR; PG8_SCHED;
            PG8_STAGE(PG8_SB(0, 1), b2 + hstepB, voffB);
            PG8_WAIT_V(6); PG8_BAR; PG8_MMA(1, 1, At, B1); PG8_BAR;
            PG8_LDB(B0, 1, 0); PG8_SCHED; PG8_LDA(At, 1, 0); PG8_STAGE(PG8_SA(0, 1), a2 + hstepA, voffA);
            PG8_WAIT_L(8); PG8_BAR; PG8_WAIT_L(0); PG8_MMA(0, 0, At, B0); PG8_BAR; PG8_SCHED;
            PG8_LDB(B1, 1, 1); PG8_STAGE(PG8_SB(1, 0), b3, voffB);
            PG8_BAR; PG8_WAIT_L(0); PG8_MMA(0, 1, At, B1); PG8_BAR;
            PG8_LDA(At, 1, 1); PG8_STAGE(PG8_SA(1, 0), a3, voffA);
            PG8_BAR; PG8_WAIT_L(0); PG8_MMA(1, 0, At, B0); PG8_BAR; PG8_SCHED;
            PG8_STAGE(PG8_SB(1, 1), b3 + hstepB, voffB);
            PG8_WAIT_V(6); PG8_BAR; PG8_MMA(1, 1, At, B1); PG8_BAR;
            }
        }
        if constexpr (ALIGN_EPI) { if (wr == 0) PG8_BAR; }
        if constexpr (!Epi::AFTER_DRAIN) { E(acc, cur, wr, wc, fr, fq); S.done(cur); }
        if (!has_next) break;
#pragma unroll
        for (int a = 0; a < 2; ++a)
#pragma unroll
            for (int b = 0; b < 2; ++b)
#pragma unroll
                for (int m = 0; m < 4; ++m)
#pragma unroll
                    for (int n = 0; n < 2; ++n) acc[a][b][m][n] = (f32x4){0.f, 0.f, 0.f, 0.f};
        cur = nxt; cA = nA; cB = nB; ++ui;
        if constexpr (ALIGN_EPI) { if (wr == 1) PG8_BAR; }
    }
    PG8_WAIT_V(0);
    if constexpr (!ALIGN_EPI) { if (wr == 0) PG8_BAR; }
    PG8_BAR;
    if constexpr (Epi::AFTER_DRAIN) { E.fused(acc, cur, wr, wc, fr, fq, lds, wid, lane); S.done(cur); }
#undef PG8_SA
#undef PG8_SB
#undef PG8_STAGE
#undef PG8_LDA
#undef PG8_LDB
#undef PG8_MMA
#undef PG8_WAIT_V
#undef PG8_WAIT_L
#undef PG8_BAR
#undef PG8_SCHED
}
}
namespace att {
typedef unsigned short bf16_t;
typedef short bf16x8 __attribute__((ext_vector_type(8)));
typedef short s16x4 __attribute__((ext_vector_type(4)));
typedef float f32x16 __attribute__((ext_vector_type(16)));
typedef unsigned u32x4 __attribute__((ext_vector_type(4)));
typedef unsigned u32x2 __attribute__((ext_vector_type(2)));
#define ATT_LAS __attribute__((address_space(3)))
constexpr int VP = 320;
constexpr int KBUF_BYTES = 64 * 400, VBUF_BYTES = 64 * VP;
constexpr int L_K0 = 0, L_V0 = 2 * KBUF_BYTES, L_LUT = L_V0 + 3 * VBUF_BYTES, L_Q = L_LUT + 512;
__device__ __forceinline__ int crow(int r, int hi) { return (r & 3) + 8 * (r >> 2) + 4 * hi; }
__device__ __forceinline__ unsigned pk2(float lo, float hi) { unsigned r; asm volatile("v_cvt_pk_bf16_f32 %0, %1, %2" : "=v"(r) : "v"(lo), "v"(hi)); return r; }
__device__ __forceinline__ float bf2f(short s) { return __uint_as_float(((unsigned)(unsigned short)s) << 16); }
__device__ __forceinline__ s16x4 vtr(const ATT_LAS unsigned char* p) { typedef short v4i16_t __attribute__((ext_vector_type(4))); return __builtin_bit_cast(s16x4, __builtin_amdgcn_ds_read_tr16_b64_v4i16((ATT_LAS v4i16_t*)p)); }
__device__ __forceinline__ int t5_bucket(int n) {
    if (n < 16) return n;
    const float v = logf((float)n / 16.0f) / 2.0794415416798357f * 16.0f;
    int b = 16 + (int)v; return b < 31 ? b : 31;
}
__device__ __forceinline__ void rope_cs(int pos, int i, float& c, float& s) {
    const float inv = exp2f(-(float)i * (13.287712379549449f / 32.0f));
    const float ang = (float)pos * inv;
    const double t = (double)ang * 0.15915494309189535; const float fr = (float)(t - floor(t));
    s = __builtin_amdgcn_sinf(fr); c = __builtin_amdgcn_cosf(fr);
}

template <int DQK, bool BIAS, bool MLA>
__device__ __forceinline__ void flash_pass(ATT_LAS unsigned char* lds, const bf16_t* __restrict__ Qp, int ldq, const bf16_t* __restrict__ Kp, int ldk, const bf16_t* __restrict__ K2p,
                                           const bf16_t* __restrict__ Vp, int ldv, const bf16_t* __restrict__ Kmp, const bf16_t* __restrict__ K2mp, const bf16_t* __restrict__ Vmp, int Q0, float sc2, f32x16 (&o)[4]) {
    constexpr int KP = DQK * 2 + 16, NS = DQK / 16, KCH = DQK / 8;
    const int tid = threadIdx.x, lane = tid & 63, wid = __builtin_amdgcn_readfirstlane(tid >> 6), r32 = lane & 31, hi = lane >> 5;
    const int q0w = 64 + Q0 + 32 * wid, qpos = q0w + r32, qld = qpos - 64;
    const ATT_LAS float* lut = (const ATT_LAS float*)(lds + L_LUT);
    bf16x8 qf[NS];
#pragma unroll
    for (int s = 0; s < NS; ++s) qf[s] = *(const bf16x8*)(Qp + (size_t)qld * ldq + 16 * s + 8 * hi);
    if (MLA) {
#pragma unroll
        for (int s = 8; s < 10; ++s)
#pragma unroll
            for (int j = 0; j < 8; ++j) { float c, sn; rope_cs(qld + 16, 16 * (s - 8) + 8 * hi + j, c, sn);
                const float x1 = bf2f(qf[s][j]), x2 = bf2f(qf[s + 2][j]); const unsigned w = pk2(x1 * c - x2 * sn, x1 * sn + x2 * c);
                qf[s][j] = (short)(w & 0xffffu); qf[s + 2][j] = (short)(w >> 16); }
    }
#pragma unroll
    for (int c = 0; c < 4; ++c)
#pragma unroll
        for (int r = 0; r < 16; ++r) o[c][r] = 0.f;
    float mrun = -INFINITY, lsum = 0.f;
    const int NT = Q0 / 64 + 5;
    constexpr int KCPR = KCH + 1, NKI = KCPR, NVI = 20;
    constexpr int NPW = (NKI + NVI + 7) / 8;
    unsigned poff[NPW];
#pragma unroll
    for (int i = 0; i < NPW; ++i) { const int pc = wid + 8 * i;
        if (pc < NKI) { const int L = 64 * pc + lane, row = L / KCPR, ch = L - row * KCPR;
            poff[i] = (MLA && ch >= 16 && ch < 24) ? (0x80000000u | (unsigned)(row * 64 + 8 * (ch - 16)) * 2u) : (unsigned)(row * ldk + 8 * (ch < (MLA ? 16 : KCH) ? ch : 0)) * 2u; }
        else { const int L = 64 * (pc - NKI) + lane, row = L / 20, ch = L - row * 20; poff[i] = (unsigned)(row * ldv + 8 * (ch < 16 ? ch : 0)) * 2u; } }
    auto issue = [&](int kt, int kslot, int vslot) __attribute__((always_inline)) {
        const char* kbase = (const char*)(kt == 0 ? Kmp : Kp + (size_t)(64 * (kt - 1)) * ldk);
        const char* vbase = (const char*)(kt == 0 ? Vmp : Vp + (size_t)(64 * (kt - 1)) * ldv);
        const char* k2base = MLA ? (const char*)(kt == 0 ? K2mp : K2p + (size_t)(64 * (kt - 1)) * 64) : nullptr;
#pragma unroll
        for (int i = 0; i < NPW; ++i) { const int pc = wid + 8 * i;
            if (pc < NKI) { const char* src = (MLA && (poff[i] >> 31)) ? k2base + (poff[i] & 0x7fffffffu) : kbase + poff[i];
                __builtin_amdgcn_global_load_lds((const unsigned*)src, (ATT_LAS unsigned*)(lds + L_K0 + kslot * KBUF_BYTES + pc * 1024), 16, 0, 0); }
            else if (pc < NKI + NVI) __builtin_amdgcn_global_load_lds((const unsigned*)(vbase + poff[i]), (ATT_LAS unsigned*)(lds + L_V0 + vslot * VBUF_BYTES + (pc - NKI) * 1024), 16, 0, 0); }
    };
    const int vlane = (4 * hi + ((lane & 15) >> 2)) * VP + (16 * ((lane >> 4) & 1) + 4 * (lane & 3)) * 2;
    u32x4 pw[4];
    auto qk_softmax = [&](int kt, int kslot) __attribute__((always_inline)) {
        const int k0 = 64 * kt;
        f32x16 p0, p1;
#pragma unroll
        for (int r = 0; r < 16; ++r) { p0[r] = 0.f; p1[r] = 0.f; }
        const ATT_LAS unsigned char* kb = lds + L_K0 + kslot * KBUF_BYTES + r32 * KP + hi * 16;
#pragma unroll
        for (int s = 0; s < NS; ++s) { const bf16x8 a0 = *(const ATT_LAS bf16x8*)(kb + s * 32), a1 = *(const ATT_LAS bf16x8*)(kb + 32 * KP + s * 32);
            p0 = __builtin_amdgcn_mfma_f32_32x32x16_bf16(a0, qf[s], p0, 0, 0, 0); p1 = __builtin_amdgcn_mfma_f32_32x32x16_bf16(a1, qf[s], p1, 0, 0, 0); }
        const bool edge = (k0 + 63 > q0w) || (kt == 0) || (BIAS && (q0w - (k0 + 63) < 113));
        float SC = sc2, C0 = BIAS ? lut[127] : 0.f;
        if (edge) {
#pragma unroll
            for (int r = 0; r < 16; ++r) {
                const int kp0 = k0 + crow(r, hi), kp1 = kp0 + 32; const int rel0 = qpos - kp0, rel1 = qpos - kp1;
                float s0 = p0[r] * sc2, s1 = p1[r] * sc2;
                if (BIAS) { s0 += lut[rel0 < 0 ? 0 : (rel0 > 127 ? 127 : rel0)]; s1 += lut[rel1 < 0 ? 0 : (rel1 > 127 ? 127 : rel1)]; }
                p0[r] = (rel0 >= 0 && kp0 >= 48) ? s0 : -INFINITY; p1[r] = (rel1 >= 0 && kp1 >= 48) ? s1 : -INFINITY;
            }
            SC = 1.f; C0 = 0.f;
        }
        float mx = fmaxf(p0[0], p1[0]);
#pragma unroll
        for (int r = 1; r < 16; ++r) mx = fmaxf(mx, fmaxf(p0[r], p1[r]));
        mx = fmaxf(mx, __shfl_xor(mx, 32)) * SC + C0;
        const float mnew = (mx > mrun + 8.0f) ? mx : mrun, muse = (mnew == -INFINITY) ? 0.f : mnew;
        const float alpha = __builtin_amdgcn_exp2f(mrun - muse); mrun = mnew;
        const float c0 = C0 - muse; float ps = 0.f;
#pragma unroll
        for (int r = 0; r < 16; ++r) { p0[r] = __builtin_amdgcn_exp2f(__builtin_fmaf(p0[r], SC, c0)); p1[r] = __builtin_amdgcn_exp2f(__builtin_fmaf(p1[r], SC, c0)); ps += p0[r] + p1[r]; }
        lsum = lsum * alpha + ps;
        if (__any(alpha != 1.f)) {
#pragma unroll
            for (int c = 0; c < 4; ++c)
#pragma unroll
                for (int r = 0; r < 16; ++r) o[c][r] *= alpha;
        }
#pragma unroll
        for (int s2 = 0; s2 < 2; ++s2) {
            pw[s2] = (u32x4){pk2(p0[8 * s2 + 0], p0[8 * s2 + 1]), pk2(p0[8 * s2 + 2], p0[8 * s2 + 3]), pk2(p0[8 * s2 + 4], p0[8 * s2 + 5]), pk2(p0[8 * s2 + 6], p0[8 * s2 + 7])};
            pw[2 + s2] = (u32x4){pk2(p1[8 * s2 + 0], p1[8 * s2 + 1]), pk2(p1[8 * s2 + 2], p1[8 * s2 + 3]), pk2(p1[8 * s2 + 4], p1[8 * s2 + 5]), pk2(p1[8 * s2 + 6], p1[8 * s2 + 7])};
        }
    };
    auto pv = [&](int vslot) __attribute__((always_inline)) {
        const ATT_LAS unsigned char* vb = lds + L_V0 + vslot * VBUF_BYTES + vlane;
#pragma unroll
        for (int sl = 0; sl < 4; ++sl) {
            const bf16x8 pf = __builtin_bit_cast(bf16x8, pw[sl]);
#pragma unroll
            for (int c = 0; c < 4; ++c) {
                const s16x4 lo = vtr(vb + (16 * sl) * VP + c * 64), hh = vtr(vb + (16 * sl + 8) * VP + c * 64);
                const bf16x8 vf = (bf16x8){lo[0], lo[1], lo[2], lo[3], hh[0], hh[1], hh[2], hh[3]};
                o[c] = __builtin_amdgcn_mfma_f32_32x32x16_bf16(vf, pf, o[c], 0, 0, 0);
            }
        }
    };
    constexpr bool SKEW = false;
    const bool late = SKEW && !MLA && wid >= 4;
    issue(0, 0, 0); asm volatile("s_waitcnt vmcnt(0)" ::: "memory"); __syncthreads();
    int vs_prev = 2, vs_cur = 0, vs_next = 1;
    for (int kt = 0; kt < NT + (SKEW && !MLA ? 1 : 0); ++kt) {
        if (kt + 1 < NT) issue(kt + 1, (kt + 1) & 1, vs_next);
        const bool act = kt < NT && 64 * kt <= q0w + 31;
        if (late && kt > 0 && 64 * (kt - 1) <= q0w + 31) pv(vs_prev);
        if (act) qk_softmax(kt, kt & 1);
        if (!late && act) pv(vs_cur);
        asm volatile("s_waitcnt vmcnt(0)" ::: "memory"); __syncthreads();
        const int t = vs_prev; vs_prev = vs_cur; vs_cur = vs_next; vs_next = t;
    }
    const float lt = lsum + __shfl_xor(lsum, 32);
    const float inv = lt > 0.f ? 1.f / lt : 0.f;
#pragma unroll
    for (int c = 0; c < 4; ++c)
#pragma unroll
        for (int r = 0; r < 16; ++r) o[c][r] *= inv;
}

struct AttnArgs {
    const bf16_t* daqkv; const bf16_t* qmla; const bf16_t* kvmla; const bf16_t* kr; const bf16_t* m_daqkv; const bf16_t* m_kvmla; const bf16_t* m_kr; bf16_t* yda; bf16_t* ymla;
    const float* table; const float* subg; const float* lq1; const float* lk1; const float* lq2; const float* lk2; int* counter;
};
template <int TYPE> __device__ __forceinline__ void attn_units(ATT_LAS unsigned char* lds, const AttnArgs& A) {
    const int tid = threadIdx.x, lane = tid & 63, wid = __builtin_amdgcn_readfirstlane(tid >> 6), r32 = lane & 31, hi = lane >> 5;
    ATT_LAS int* qslot = (ATT_LAS int*)(lds + L_Q);
    ATT_LAS float* lut = (ATT_LAS float*)(lds + L_LUT);
    constexpr int NJ = 32, TOTAL = NJ * 16;
    for (;;) {
        __syncthreads();
        if (tid == 0) *qslot = atomicAdd(A.counter + TYPE, 1);
        __syncthreads();
        const int u = *qslot;
        if (u >= TOTAL) break;
        const int j = NJ - 1 - (u >> 4), rem = u & 15, b = rem >> 3, h = rem & 7;
        const int Q0 = 256 * j; const size_t brow = (size_t)b * SEQ;
        const int qpos = Q0 + 32 * wid + r32;
        f32x16 o[4];
        if (TYPE == 0) {
            float lam;
            { float a = A.lq1[lane] * A.lk1[lane], bb = A.lq2[lane] * A.lk2[lane];
#pragma unroll
              for (int off = 1; off < 64; off <<= 1) { a += __shfl_xor(a, off); bb += __shfl_xor(bb, off); }
              lam = expf(a) - expf(bb) + 0.2f; }
            if (tid < 128) lut[tid] = A.table[t5_bucket(tid) * 8 + h] * LOG2E;
            bf16_t* orow = A.yda + (brow + qpos) * 1024 + h * 128;
#pragma unroll
            for (int comp = 0; comp < 2; ++comp) {
                const bf16_t* base = A.daqkv + brow * 3072 + h * 128;
                const bf16_t* mb = A.m_daqkv + h * 128;
                flash_pass<64, true, false>(lds, base + comp * 64, 3072, base + 1024 + comp * 64, 3072, nullptr, base + 2048, 3072, mb + 1024 + comp * 64, nullptr, mb + 2048, Q0, 0.125f * LOG2E, o);
                if (comp == 0) {
#pragma unroll
                    for (int c = 0; c < 4; ++c)
#pragma unroll
                        for (int g4 = 0; g4 < 4; ++g4) { u32x2 w; w.x = pk2(o[c][4 * g4 + 0], o[c][4 * g4 + 1]); w.y = pk2(o[c][4 * g4 + 2], o[c][4 * g4 + 3]); *(u32x2*)(orow + 32 * c + 8 * g4 + 4 * hi) = w; }
                }
            }
            float ss = 0.f;
#pragma unroll
            for (int c = 0; c < 4; ++c)
#pragma unroll
                for (int g4 = 0; g4 < 4; ++g4) { const u32x2 w = *(const u32x2*)(orow + 32 * c + 8 * g4 + 4 * hi);
                    const float y0 = __uint_as_float(w.x << 16) - lam * o[c][4 * g4 + 0], y1 = __uint_as_float(w.x & 0xffff0000u) - lam * o[c][4 * g4 + 1];
                    const float y2 = __uint_as_float(w.y << 16) - lam * o[c][4 * g4 + 2], y3 = __uint_as_float(w.y & 0xffff0000u) - lam * o[c][4 * g4 + 3];
                    o[c][4 * g4 + 0] = y0; o[c][4 * g4 + 1] = y1; o[c][4 * g4 + 2] = y2; o[c][4 * g4 + 3] = y3; ss += (y0 * y0 + y1 * y1) + (y2 * y2 + y3 * y3); }
            ss += __shfl_xor(ss, 32);
            const float rstd = __builtin_amdgcn_rsqf(ss * (1.f / 128.f) + RMS_EPS) * 0.8f;
            {
#pragma unroll
                for (int c = 0; c < 4; ++c)
#pragma unroll
                    for (int g4 = 0; g4 < 4; ++g4) { const int d0 = 32 * c + 8 * g4 + 4 * hi; const float4 gv = *(const float4*)(A.subg + d0);
                        u32x2 w; w.x = pk2(o[c][4 * g4 + 0] * rstd * gv.x, o[c][4 * g4 + 1] * rstd * gv.y); w.y = pk2(o[c][4 * g4 + 2] * rstd * gv.z, o[c][4 * g4 + 3] * rstd * gv.w);
                        *(u32x2*)(orow + d0) = w; }
            }
        } else {
            flash_pass<192, false, true>(lds, A.qmla + brow * 1536 + h * 192, 1536, A.kvmla + brow * 2048 + h * 256, 2048, A.kr + brow * 64, A.kvmla + brow * 2048 + h * 256 + 128, 2048,
                                         A.m_kvmla + h * 256, A.m_kr, A.m_kvmla + h * 256 + 128, Q0,
                                         0.07216878364870322f * LOG2E, o);
            {
                bf16_t* orow = A.ymla + (brow + qpos) * 1024 + h * 128;
#pragma unroll
                for (int c = 0; c < 4; ++c)
#pragma unroll
                    for (int g4 = 0; g4 < 4; ++g4) { const int d0 = 32 * c + 8 * g4 + 4 * hi;
                        u32x2 w; w.x = pk2(o[c][4 * g4 + 0], o[c][4 * g4 + 1]); w.y = pk2(o[c][4 * g4 + 2], o[c][4 * g4 + 3]);
                        *(u32x2*)(orow + d0) = w; }
            }
        }
    }
}
__device__ __forceinline__ void attn_phase(ATT_LAS unsigned char* lds, const AttnArgs& A) {
#ifndef ATT_TYPES
#define ATT_TYPES 3
#endif
    if (ATT_TYPES & 1) attn_units<0>(lds, A);
    if (ATT_TYPES & 2) attn_units<1>(lds, A);
}
}
typedef unsigned short bf16_t;
typedef float f32x4 __attribute__((ext_vector_type(4)));
typedef unsigned u32x4 __attribute__((ext_vector_type(4)));
typedef unsigned u32x2 __attribute__((ext_vector_type(2)));
#define LAS __attribute__((address_space(3)))

#define XB_TMO      128
#define XB_XCNT(j)  (256  + 64 * (j))
#define XB_XSUB(j)  (1280 + 64 * (j))
#define XB_XGEN(j)  (2304 + 64 * (j))
#define XB_TOP      3328
#define XB_TOPGEN   3392
#define XCD_BAR_WORDS 3456
#define XB_SPIN_CAP (1u << 18)

__device__ __forceinline__ unsigned xb_ld(unsigned* p)              { return __hip_atomic_load(p, __ATOMIC_RELAXED, __HIP_MEMORY_SCOPE_AGENT); }
__device__ __forceinline__ unsigned xb_add(unsigned* p, unsigned v) { return __hip_atomic_fetch_add(p, v, __ATOMIC_RELAXED, __HIP_MEMORY_SCOPE_AGENT); }
__device__ __forceinline__ unsigned xb_xcc_id() { return (unsigned)__builtin_amdgcn_s_getreg((3 << 11) | 20) & 0xFu; }
#define XB_SPIN(cond, bar) do { unsigned _sp = 0; while (cond) { __builtin_amdgcn_s_sleep(1); \
    if ((++_sp & 255u) == 0u) { if (xb_ld(&(bar)[XB_TMO])) break; if (_sp > XB_SPIN_CAP) { atomicAdd(&(bar)[XB_TMO], 1u); break; } } } } while (0)

struct XcdBarrier {
    unsigned* bar; unsigned x;
    volatile LAS unsigned* st;
};

__device__ __forceinline__ XcdBarrier xcd_barrier_post(unsigned* bar, volatile LAS unsigned* st) {
    XcdBarrier b; b.bar = bar; b.x = xb_xcc_id(); b.st = st;
    if (threadIdx.x == 0) (void)xb_add(&bar[XB_XCNT(b.x)], 1u);
    return b;
}
__device__ __forceinline__ void xcd_barrier_complete(unsigned* bar, unsigned x, unsigned& nloc, unsigned& nx) {
    const unsigned G = gridDim.x * gridDim.y * gridDim.z;
    unsigned sum, cnt, mine, sp = 0u;
    for (;;) {
        sum = 0u; cnt = 0u; mine = 0u;
#pragma unroll
        for (unsigned j = 0; j < 16; ++j) { const unsigned c = xb_ld(&bar[XB_XCNT(j)]); sum += c; cnt += (c > 0u) ? 1u : 0u; mine = (j == x) ? c : mine; }
        if (sum == G) break;
        __builtin_amdgcn_s_sleep(1);
        if ((++sp & 255u) == 0u) { if (xb_ld(&bar[XB_TMO])) break; if (sp > XB_SPIN_CAP) { atomicAdd(&bar[XB_TMO], 1u); break; } }
    }
    nloc = mine > 0u ? mine : 1u; nx = cnt > 0u ? cnt : 1u;
}

__device__ __forceinline__ void xcd_barrier(const XcdBarrier& b) {
    asm volatile("s_waitcnt vmcnt(0)" ::: "memory");
    __syncthreads();
    if (threadIdx.x == 0) {
        unsigned* bar = b.bar;
        __builtin_amdgcn_s_waitcnt(0);
        unsigned nloc = b.st[0], nx = b.st[1];
        if (nloc == 0u) { xcd_barrier_complete(bar, b.x, nloc, nx); b.st[0] = nloc; b.st[1] = nx; }
        const unsigned old = xb_add(&bar[XB_XSUB(b.x)], 1u);
        const unsigned gen = old / nloc;
        if (old + 1u == (gen + 1u) * nloc) {
            __builtin_amdgcn_fence(__ATOMIC_RELEASE, "agent");
            asm volatile("s_waitcnt vmcnt(0)" ::: "memory");
            const unsigned og = xb_add(&bar[XB_TOP], 1u);
            const unsigned tg = og / nx;
            if (og + 1u == (tg + 1u) * nx) xb_add(&bar[XB_TOPGEN], 1u);
            else XB_SPIN(xb_ld(&bar[XB_TOPGEN]) == tg, bar);
            __builtin_amdgcn_fence(__ATOMIC_ACQUIRE, "agent");
            xb_add(&bar[XB_XGEN(b.x)], 1u);
            asm volatile("s_waitcnt vmcnt(0)" ::: "memory");
        } else {
            XB_SPIN(xb_ld(&bar[XB_XGEN(b.x)]) == gen, bar);
            __builtin_amdgcn_fence(__ATOMIC_ACQUIRE, "agent");
            asm volatile("s_waitcnt vmcnt(0)" ::: "memory");
        }
    }
    __syncthreads();
}


struct Params {
    const float* in[29];
    float* out; unsigned char* ws;
    int ph_lo, ph_hi;
};
enum { I_X = 0, I_META, I_TABLE, I_F1PRE, I_F1POST, I_F1G, I_F1U, I_F1D, I_MIXPRE, I_MIXPOST, I_WIN, I_BGATE, I_LQ1, I_LK1, I_LQ2, I_LK2, I_SUBG, I_QNG, I_KVNG, I_WUQ, I_WUKV,
       I_WBDA, I_WBMLA, I_WOUT, I_F2PRE, I_F2POST, I_F2G, I_F2U, I_F2D };

__device__ __forceinline__ float wave_sum(float v) {
#pragma unroll
    for (int o = 1; o < 64; o <<= 1) v += __shfl_xor(v, o);
    return v;
}
__device__ __forceinline__ unsigned pkbf(float lo, float hi) { unsigned r; asm volatile("v_cvt_pk_bf16_f32 %0, %1, %2" : "=v"(r) : "v"(lo), "v"(hi)); return r; }

struct CvtJob { const float* src; bf16_t* dst; const float* kscale; int K, N, mode; };
__device__ __forceinline__ int cvt_maprow(int mode, int n) {
    if (mode == 1) return 256 * (n >> 7) + (n & 127);
    if (mode == 2) return 256 * (n >> 7) + 128 + (n & 127);
    if (mode == 3) return n < 4416 ? n + 4096 : n - 4416;
    return n;
}
__device__ __forceinline__ void cvt_load(const CvtJob& jb, int t, f32x4 (&a)[8]) {
    const int lane = threadIdx.x & 63, nbn = jb.N >> 5, kb = t / nbn, nb = t - kb * nbn, k0 = kb * 64, n0 = nb * 32, rr = lane >> 3, c4 = (lane & 7) * 4;
#pragma unroll
    for (int i = 0; i < 8; ++i) a[i] = __builtin_nontemporal_load((const f32x4*)(jb.src + (size_t)(k0 + 8 * i + rr) * jb.N + n0 + c4));
}
__device__ __forceinline__ void cvt_finish(const CvtJob& jb, int t, const f32x4 (&a)[8], LAS float* scr) {
    const int lane = threadIdx.x & 63, nbn = jb.N >> 5, kb = t / nbn, nb = t - kb * nbn, k0 = kb * 64, n0 = nb * 32;
    { const int rr = lane >> 3, c4 = (lane & 7) * 4;
#pragma unroll
      for (int i = 0; i < 8; ++i) { const int k = 8 * i + rr; const float sc = jb.kscale ? jb.kscale[k0 + k] : 1.f;
          LAS float* d = scr + k * 33 + c4; d[0] = a[i][0] * sc; d[1] = a[i][1] * sc; d[2] = a[i][2] * sc; d[3] = a[i][3] * sc; } }
    asm volatile("s_waitcnt lgkmcnt(0)" ::: "memory");
    { const int kc = (lane & 7) * 8;
#pragma unroll
      for (int j = 0; j < 4; ++j) { const int nn = (lane >> 3) + 8 * j; const LAS float* s = scr + kc * 33 + nn;
          u32x4 w; w.x = pkbf(s[0], s[33]); w.y = pkbf(s[66], s[99]); w.z = pkbf(s[132], s[165]); w.w = pkbf(s[198], s[231]);
          *(u32x4*)(jb.dst + (size_t)cvt_maprow(jb.mode, n0 + nn) * jb.K + k0 + kc) = w; } }
    asm volatile("s_waitcnt lgkmcnt(0)" ::: "memory");
}
__device__ __forceinline__ CvtJob cvt_job(const Params& p, int j) {
    unsigned char* ws = p.ws; CvtJob r;
    switch (j) {
    case 0: r = CvtJob{p.in[I_WIN], (bf16_t*)(ws + OFF_WIN), nullptr, 2048, 8512, 3}; break;
    case 1: r = CvtJob{p.in[I_WUQ], (bf16_t*)(ws + OFF_WUQ), p.in[I_QNG], 768, 1536, 0}; break;
    case 2: r = CvtJob{p.in[I_WUKV], (bf16_t*)(ws + OFF_WUKV), p.in[I_KVNG], 512, 2048, 0}; break;
    case 3: r = CvtJob{p.in[I_WBDA], (bf16_t*)(ws + OFF_WBDA), nullptr, 1024, 2048, 0}; break;
    case 4: r = CvtJob{p.in[I_WBMLA], (bf16_t*)(ws + OFF_WBMLA), nullptr, 1024, 2048, 0}; break;
    case 5: r = CvtJob{p.in[I_WOUT], (bf16_t*)(ws + OFF_WOUT), nullptr, 2048, 2048, 0}; break;
    case 6: r = CvtJob{p.in[I_F1G], (bf16_t*)(ws + OFF_FFN), nullptr, 2048, 5632, 1}; break;
    case 7: r = CvtJob{p.in[I_F1U], (bf16_t*)(ws + OFF_FFN), nullptr, 2048, 5632, 2}; break;
    case 8: r = CvtJob{p.in[I_F1D], (bf16_t*)(ws + OFF_WD), nullptr, 5632, 2048, 0}; break;
    case 9: r = CvtJob{p.in[I_F2G], (bf16_t*)(ws + OFF_FFN), nullptr, 2048, 5632, 1}; break;
    case 10: r = CvtJob{p.in[I_F2U], (bf16_t*)(ws + OFF_FFN), nullptr, 2048, 5632, 2}; break;
    default: r = CvtJob{p.in[I_F2D], (bf16_t*)(ws + OFF_WD), nullptr, 5632, 2048, 0}; break;
    }
    return r;
}
template <int JLO, int JHI> __device__ __forceinline__ void cvt_jobs(const Params& p, LAS float* tile) {
    const int wid = threadIdx.x >> 6, nw = (int)gridDim.x * 8, gw = (int)blockIdx.x * 8 + wid;
    LAS float* scr = tile + wid * (64 * 33);
    int base = 0;
#pragma unroll
    for (int j = JLO; j < JHI; ++j) {
        const CvtJob jb = cvt_job(p, j); const int nt = (jb.K >> 6) * (jb.N >> 5);
        int t = (gw - base % nw + nw) % nw;
        f32x4 ra[8], rb[8];
        if (t < nt) cvt_load(jb, t, ra);
        for (; t < nt; t += 2 * nw) {
            const int t1 = t + nw, t2 = t + 2 * nw;
            if (t1 < nt) cvt_load(jb, t1, rb);
            cvt_finish(jb, t, ra, scr);
            if (t1 < nt) { if (t2 < nt) cvt_load(jb, t2, ra); cvt_finish(jb, t1, rb, scr); }
        }
        base += nt;
    }
    __syncthreads();
}

__device__ __forceinline__ void norm_rows(const Params& p, bool src_input, const bf16_t* f, float coef, const float* gpost, const float* gnext) {
    const int lane = threadIdx.x & 63, wid = threadIdx.x >> 6;
    bf16_t* HN = (bf16_t*)(p.ws + OFF_HN);
    for (int row = blockIdx.x * 8 + wid; row < MROWS; row += gridDim.x * 8) {
        const float* hsrc = (src_input ? p.in[I_X] : p.out) + (size_t)row * D;
        f32x4 hv[8];
#pragma unroll
        for (int i = 0; i < 8; ++i) hv[i] = __builtin_nontemporal_load((const f32x4*)hsrc + lane + 64 * i);
        if (f) {
            f32x4 fv[8]; float ss = 0.f;
#pragma unroll
            for (int i = 0; i < 8; ++i) { const u32x2 w = __builtin_nontemporal_load((const u32x2*)(f + (size_t)row * D) + lane + 64 * i); fv[i] = (f32x4){__uint_as_float(w.x << 16), __uint_as_float(w.x & 0xffff0000u), __uint_as_float(w.y << 16), __uint_as_float(w.y & 0xffff0000u)};
                ss += (fv[i][0] * fv[i][0] + fv[i][1] * fv[i][1]) + (fv[i][2] * fv[i][2] + fv[i][3] * fv[i][3]); }
            const float r = coef * __builtin_amdgcn_rsqf(wave_sum(ss) * (1.f / D) + RMS_EPS);
#pragma unroll
            for (int i = 0; i < 8; ++i) { const f32x4 g = ((const f32x4*)gpost)[lane + 64 * i]; hv[i] = hv[i] + fv[i] * g * r; }
            float* hd = p.out + (size_t)row * D;
#pragma unroll
            for (int i = 0; i < 8; ++i) __builtin_nontemporal_store(hv[i], (f32x4*)hd + lane + 64 * i);
        }
        if (gnext) {
            float ss = 0.f;
#pragma unroll
            for (int i = 0; i < 8; ++i) ss += (hv[i][0] * hv[i][0] + hv[i][1] * hv[i][1]) + (hv[i][2] * hv[i][2] + hv[i][3] * hv[i][3]);
            const float r = __builtin_amdgcn_rsqf(wave_sum(ss) * (1.f / D) + RMS_EPS);
            u32x2* o = (u32x2*)(HN + (size_t)row * D);
#pragma unroll
            for (int i = 0; i < 8; ++i) { const f32x4 g = ((const f32x4*)gnext)[lane + 64 * i]; const f32x4 v = hv[i] * g * r; o[lane + 64 * i] = (u32x2){pkbf(v[0], v[1]), pkbf(v[2], v[3])}; }
        }
    }
}
__device__ __forceinline__ void norm_meta(const Params& p, const float* f, const float* gpost, const float* gnext, bf16_t* HNM) {
    if (blockIdx.x != gridDim.x - 1) return;
    const int lane = threadIdx.x & 63, wid = threadIdx.x >> 6;
    for (int row = wid; row < 16; row += 8) {
        f32x4 hv[8];
#pragma unroll
        for (int i = 0; i < 8; ++i) hv[i] = ((const f32x4*)(p.in[I_META] + (size_t)row * D))[lane + 64 * i];
        if (f) {
            f32x4 fv[8]; float ss = 0.f;
#pragma unroll
            for (int i = 0; i < 8; ++i) { fv[i] = ((const f32x4*)(f + (size_t)row * D))[lane + 64 * i]; ss += (fv[i][0] * fv[i][0] + fv[i][1] * fv[i][1]) + (fv[i][2] * fv[i][2] + fv[i][3] * fv[i][3]); }
            const float r = 0.5f * __builtin_amdgcn_rsqf(wave_sum(ss) * (1.f / D) + RMS_EPS);
#pragma unroll
            for (int i = 0; i < 8; ++i) { const f32x4 g = ((const f32x4*)gpost)[lane + 64 * i]; hv[i] = hv[i] + fv[i] * g * r; }
        }
        float ss = 0.f;
#pragma unroll
        for (int i = 0; i < 8; ++i) ss += (hv[i][0] * hv[i][0] + hv[i][1] * hv[i][1]) + (hv[i][2] * hv[i][2] + hv[i][3] * hv[i][3]);
        const float r = __builtin_amdgcn_rsqf(wave_sum(ss) * (1.f / D) + RMS_EPS);
        u32x2* o = (u32x2*)(HNM + (size_t)row * D);
#pragma unroll
        for (int i = 0; i < 8; ++i) { const f32x4 g = ((const f32x4*)gnext)[lane + 64 * i]; const f32x4 v = hv[i] * g * r; o[lane + 64 * i] = (u32x2){pkbf(v[0], v[1]), pkbf(v[2], v[3])}; }
    }
}
__device__ __forceinline__ void rope_k_rows(const Params& p) {
    const bf16_t* cb = (const bf16_t*)(p.ws + OFF_CBUF); bf16_t* kr = (bf16_t*)(p.ws + OFF_KR);
    const bf16_t* cm = (const bf16_t*)(p.ws + OFF_M_C); bf16_t* krm = (bf16_t*)(p.ws + OFF_M_KR);
    const int total = (MROWS + 16) * 32;
    for (int idx = blockIdx.x * 512 + threadIdx.x; idx < total; idx += gridDim.x * 512) {
        const int row = idx >> 5, i = idx & 31; const bool meta = row >= MROWS;
        const int pos = meta ? row - MROWS : 16 + (row & (SEQ - 1));
        const bf16_t* src = meta ? cm + (size_t)(row - MROWS) * CP : cb + (size_t)row * CP;
        bf16_t* dst = meta ? krm + (size_t)(48 + row - MROWS) * 64 : kr + (size_t)row * 64;
        float c, sn; att::rope_cs(pos, i, c, sn);
        const float x1 = __uint_as_float((unsigned)src[1280 + i] << 16), x2 = __uint_as_float((unsigned)src[1312 + i] << 16);
        const unsigned w = pkbf(x1 * c - x2 * sn, x1 * sn + x2 * c);
        dst[i] = (bf16_t)(w & 0xffffu); dst[32 + i] = (bf16_t)(w >> 16);
    }
}
typedef short bf16x8_t __attribute__((ext_vector_type(8)));
template <int NACC, class F>
__device__ __forceinline__ void skinny_block(LAS unsigned char* lds, const bf16_t* A, int lda, const bf16_t* B0, const bf16_t* B1, int ldb, int K, F&& f) {
    const int lane = threadIdx.x & 63, wid = threadIdx.x >> 6, fr = lane & 15, fq = lane >> 4, kw = K >> 3;
    const bf16_t* ap = A + (size_t)fr * lda + wid * kw + 8 * fq;
    const bf16_t* bp0 = B0 + (size_t)fr * ldb + wid * kw + 8 * fq; const bf16_t* bp1 = B1 + (size_t)fr * ldb + wid * kw + 8 * fq;
    f32x4 acc0[4], acc1[4];
#pragma unroll
    for (int c = 0; c < 4; ++c) { acc0[c] = (f32x4){0.f, 0.f, 0.f, 0.f}; acc1[c] = acc0[c]; }
    for (int k = 0; k < kw; k += 32) {
        const bf16x8_t a = *(const bf16x8_t*)(ap + k);
#pragma unroll
        for (int c = 0; c < 4; ++c) {
            const bf16x8_t b0 = *(const bf16x8_t*)(bp0 + (size_t)(16 * c) * ldb + k);
            acc0[c] = __builtin_amdgcn_mfma_f32_16x16x32_bf16(a, b0, acc0[c], 0, 0, 0);
            if (NACC == 2) { const bf16x8_t b1 = *(const bf16x8_t*)(bp1 + (size_t)(16 * c) * ldb + k); acc1[c] = __builtin_amdgcn_mfma_f32_16x16x32_bf16(a, b1, acc1[c], 0, 0, 0); }
        }
    }
    LAS f32x4* red = (LAS f32x4*)lds;
#pragma unroll
    for (int c = 0; c < 4; ++c) { red[(c * 8 + wid) * 64 + lane] = acc0[c]; if (NACC == 2) red[((4 + c) * 8 + wid) * 64 + lane] = acc1[c]; }
    __syncthreads();
    if (wid == 0) {
#pragma unroll
        for (int c = 0; c < 4; ++c) {
            f32x4 s0 = red[(c * 8) * 64 + lane];
#pragma unroll
            for (int w = 1; w < 8; ++w) s0 = s0 + red[(c * 8 + w) * 64 + lane];
            acc0[c] = s0;
            if (NACC == 2) { f32x4 s1 = red[((4 + c) * 8) * 64 + lane];
#pragma unroll
                for (int w = 1; w < 8; ++w) s1 = s1 + red[((4 + c) * 8 + w) * 64 + lane];
                acc1[c] = s1; }
        }
        f(acc0, acc1, fr, 4 * fq);
    }
    __syncthreads();
}
#define SKINNY_FOR(blk, nblk) for (int blk = (int)gridDim.x - 1 - (int)blockIdx.x; blk < (nblk); blk += (int)gridDim.x)

template <class Epi> __device__ __forceinline__ void run_gemm(LAS unsigned char* lds, const bf16_t* A, int lda, const bf16_t* Bt, int ldb, int N, int K, const Epi& E) {
    pg8::Gemm g{A, Bt, MROWS, N, K, lda, ldb}; pg8::StaticOrder S; S.init(MROWS, N, gridDim.x, blockIdx.x);
    pg8::gemm_phase<Epi, pg8::StaticOrder, true, true>(lds, g, S, E);
}

#ifndef USE_GRID_SYNC
#define USE_GRID_SYNC 1
#endif
constexpr int NPHASE = 13;
constexpr int LDS_BYTES = 132096;

__global__ void __launch_bounds__(512, 2) fwd_kernel(Params p) {
    extern __shared__ __attribute__((aligned(16))) unsigned char lds_raw[];
    LAS unsigned char* lds = (LAS unsigned char*)lds_raw;
    unsigned char* ws = p.ws;
#define HN ((bf16_t*)(ws + OFF_HN))
#define FB ((bf16_t*)(ws + OFF_F))
#define ACT ((bf16_t*)(ws + OFF_BIG))
#define GATES ((bf16_t*)(ws + OFF_F))
#define DAQKV ((bf16_t*)(ws + OFF_BIG))
#define CBUF ((bf16_t*)(ws + OFF_CBUF))
#define QMLA ((bf16_t*)(ws + OFF_QMLA))
#define KVMLA ((bf16_t*)(ws + OFF_FFN))
#define KR ((bf16_t*)(ws + OFF_KR))
#define YDA HN
#define YMLA (HN + (size_t)MROWS * 1024)
#define TMP ((bf16_t*)(ws + OFF_BIG))
#define MERGED ((bf16_t*)(ws + OFF_FFN))
#define RSQ ((float*)(ws + OFF_RSQ))
#define RSKV ((float*)(ws + OFF_RSKV))
#define CTL ((int*)(ws + OFF_CTL))
    const int gtid = blockIdx.x * 512 + threadIdx.x, gthreads = gridDim.x * 512;
#if USE_GRID_SYNC
    cg::grid_group grid = cg::this_grid();
    { volatile LAS unsigned* st = (volatile LAS unsigned*)(lds + 131072); if (threadIdx.x < 2) st[threadIdx.x] = 0u; __syncthreads(); }
    XcdBarrier bar = xcd_barrier_post((unsigned*)(ws + OFF_CTL + 16384), (volatile LAS unsigned*)(lds + 131072));
    if (p.ph_lo < 0) grid.sync();
#define SEAM(ph) do { if ((ph) + 1 < p.ph_hi) xcd_barrier(bar); } while (0)
#else
#define SEAM(ph) do { } while (0)
#endif
#ifndef PHMASK
#define PHMASK 0x1fff
#endif
#define IN(ph) (((PHMASK >> (ph)) & 1) && p.ph_lo <= (ph) && (ph) < p.ph_hi)
#define M_HN ((bf16_t*)(ws + OFF_M_HN))
#define M_ACT ((bf16_t*)(ws + OFF_M_ACT))
#define M_F ((float*)(ws + OFF_M_F))
#define M_C ((bf16_t*)(ws + OFF_M_C))
#define M_HN2 ((bf16_t*)(ws + OFF_M_HN2))
#define M_DAQKV ((bf16_t*)(ws + OFF_M_DAQKV))
#define M_KVMLA ((bf16_t*)(ws + OFF_M_KVMLA))
#define M_KR ((bf16_t*)(ws + OFF_M_KR))
    if (IN(0)) {
        for (int i = gtid; i < 2 * MROWS; i += gthreads) { if (i < MROWS) RSQ[i] = 0.f; else RSKV[i - MROWS] = 0.f; }
        if (gtid < 64) CTL[gtid] = 0;
        { u32x4* z = (u32x4*)((bf16_t*)(ws + OFF_WIN) + (size_t)8512 * 2048); for (int i = gtid; i < 192 * 2048 / 8; i += gthreads) z[i] = (u32x4){0u, 0u, 0u, 0u}; }
        for (int i = gtid; i < (48 * 3072 + 48 * 2048 + 48 * 64) / 8; i += gthreads) {
            u32x4* z = i < 48 * 3072 / 8 ? (u32x4*)(ws + OFF_M_DAQKV) + i : (i < (48 * 3072 + 48 * 2048) / 8 ? (u32x4*)(ws + OFF_M_KVMLA) + (i - 48 * 3072 / 8) : (u32x4*)(ws + OFF_M_KR) + (i - (48 * 3072 + 48 * 2048) / 8));
            *z = (u32x4){0u, 0u, 0u, 0u}; }
        norm_rows(p, true, nullptr, 0.f, nullptr, p.in[I_F1PRE]);
        norm_meta(p, nullptr, nullptr, p.in[I_F1PRE], M_HN);
        cvt_jobs<0, 9>(p, (LAS float*)lds);
        SEAM(0);
    }
    if (IN(1)) {
        { pg8::EpiAct E{ACT}; run_gemm(lds, HN, D, (const bf16_t*)(ws + OFF_FFN), D, 2 * FF, D, E); }
        __syncthreads();
        SKINNY_FOR(blk, FF / 64) {
            const int n0 = 64 * blk; const bf16_t* B0 = (const bf16_t*)(ws + OFF_FFN) + (size_t)(256 * (n0 >> 7) + (n0 & 127)) * D;
            skinny_block<2>(lds, M_HN, D, B0, B0 + (size_t)128 * D, D, D, [&](const f32x4 (&g)[4], const f32x4 (&u)[4], int n, int m0) {
#pragma unroll
                for (int c = 0; c < 4; ++c)
#pragma unroll
                    for (int r = 0; r < 4; ++r) M_ACT[(size_t)(m0 + r) * FF + n0 + 16 * c + n] = (bf16_t)(pkbf(g[c][r] * pg8::sigmoidf_(g[c][r]) * u[c][r], 0.f) & 0xffffu); });
        }
        SEAM(1);
    }
    if (IN(2)) {
        { pg8::EpiBf16 E{FB, D}; run_gemm(lds, ACT, FF, (const bf16_t*)(ws + OFF_WD), FF, D, FF, E); }
        __syncthreads();
        SKINNY_FOR(blk, D / 64) {
            const int n0 = 64 * blk; const bf16_t* B0 = (const bf16_t*)(ws + OFF_WD) + (size_t)n0 * FF;
            skinny_block<1>(lds, M_ACT, FF, B0, B0, FF, FF, [&](const f32x4 (&v)[4], const f32x4 (&)[4], int n, int m0) {
#pragma unroll
                for (int c = 0; c < 4; ++c)
#pragma unroll
                    for (int r = 0; r < 4; ++r) M_F[(size_t)(m0 + r) * D + n0 + 16 * c + n] = v[c][r]; });
        }
        SEAM(2);
    }
    if (IN(3)) { norm_rows(p, true, FB, 0.5f, p.in[I_F1POST], p.in[I_MIXPRE]); norm_meta(p, M_F, p.in[I_F1POST], p.in[I_MIXPRE], M_HN2); SEAM(3); }
    if (IN(4)) {
        { pg8::EpiInProj E{GATES, DAQKV, CBUF, p.in[I_BGATE], RSQ, RSKV}; run_gemm(lds, HN, D, (const bf16_t*)(ws + OFF_WIN), D, NIN, D, E); }
        __syncthreads();
        SKINNY_FOR(blk, 41) {
            const int nrow = blk < 32 ? 5120 + 64 * blk : (blk < 40 ? 7936 + 64 * (blk - 32) : 8448);
            const bf16_t* B0 = (const bf16_t*)(ws + OFF_WIN) + (size_t)nrow * D;
            bf16_t* dst = blk < 32 ? M_DAQKV + (size_t)48 * 3072 + (nrow - 4096) : M_C + (blk < 40 ? 768 + (nrow - 7936) : 1280);
            const int ldd = blk < 32 ? 3072 : CP;
            skinny_block<1>(lds, M_HN2, D, B0, B0, D, D, [&](const f32x4 (&v)[4], const f32x4 (&)[4], int n, int m0) {
#pragma unroll
                for (int c = 0; c < 4; ++c)
#pragma unroll
                    for (int r = 0; r < 4; ++r) dst[(size_t)(m0 + r) * ldd + 16 * c + n] = (bf16_t)(pkbf(v[c][r], 0.f) & 0xffffu); });
        }
        SEAM(4);
    }
    if (IN(5)) {
        { pg8::EpiRowScale E{QMLA, 1536, RSQ, 1.f / 768.f}; run_gemm(lds, CBUF, CP, (const bf16_t*)(ws + OFF_WUQ), 768, 1536, 768, E); }
        __syncthreads();
        { pg8::EpiRowScale E{KVMLA, 2048, RSKV, 1.f / 512.f}; run_gemm(lds, CBUF + 768, CP, (const bf16_t*)(ws + OFF_WUKV), 512, 2048, 512, E); }
        __syncthreads();
        {
            LAS float* rsl = (LAS float*)(lds + 98304); const int lane = threadIdx.x & 63, wid = threadIdx.x >> 6;
            for (int rr = 2 * wid; rr < 2 * wid + 2; ++rr) { const u32x4 w = *(const u32x4*)(M_C + (size_t)rr * CP + 768 + 8 * lane); float ss = 0.f;
#define SQ2(x) { const float lo_ = __uint_as_float((x) << 16), hi_ = __uint_as_float((x) & 0xffff0000u); ss += lo_ * lo_ + hi_ * hi_; }
                SQ2(w.x) SQ2(w.y) SQ2(w.z) SQ2(w.w)
#undef SQ2
                ss = wave_sum(ss); if (lane == 0) rsl[rr] = ss; }
            __syncthreads();
            SKINNY_FOR(blk, D / 64) {
                const int n0 = 64 * blk; const bf16_t* B0 = (const bf16_t*)(ws + OFF_WUKV) + (size_t)n0 * 512;
                skinny_block<1>(lds, M_C + 768, CP, B0, B0, 512, 512, [&](const f32x4 (&v)[4], const f32x4 (&)[4], int n, int m0) {
#pragma unroll
                    for (int r = 0; r < 4; ++r) { const float sc = __builtin_amdgcn_rsqf(rsl[m0 + r] * (1.f / 512.f) + RMS_EPS);
#pragma unroll
                        for (int c = 0; c < 4; ++c) M_KVMLA[(size_t)(48 + m0 + r) * 2048 + n0 + 16 * c + n] = (bf16_t)(pkbf(v[c][r] * sc, 0.f) & 0xffffu); } });
            }
        }
        rope_k_rows(p);
        SEAM(5);
    }
    if (IN(6)) {
        att::AttnArgs A{DAQKV, QMLA, KVMLA, KR, M_DAQKV, M_KVMLA, M_KR, YDA, YMLA, p.in[I_TABLE], p.in[I_SUBG], p.in[I_LQ1], p.in[I_LK1], p.in[I_LQ2], p.in[I_LK2], CTL + 0};
        if (threadIdx.x >= 256) __builtin_amdgcn_s_setprio(1);
        att::attn_phase(lds, A);
        __builtin_amdgcn_s_setprio(0);
        SEAM(6);
    }
    if (IN(7)) {
        { pg8::EpiGate<0> E{GATES, TMP, MERGED, p.in[I_BGATE]}; run_gemm(lds, YDA, 1024, (const bf16_t*)(ws + OFF_WBDA), 1024, D, 1024, E); }
        __syncthreads();
        { pg8::EpiGate<1> E{GATES, TMP, MERGED, p.in[I_BGATE]}; run_gemm(lds, YMLA, 1024, (const bf16_t*)(ws + OFF_WBMLA), 1024, D, 1024, E); }
        SEAM(7);
    }
    if (IN(8)) { pg8::EpiBf16 E{FB, D}; run_gemm(lds, MERGED, D, (const bf16_t*)(ws + OFF_WOUT), D, D, D, E); SEAM(8); }
    if (IN(9)) { norm_rows(p, false, FB, 1.0f, p.in[I_MIXPOST], p.in[I_F2PRE]); cvt_jobs<9, 12>(p, (LAS float*)lds); SEAM(9); }
    if (IN(10)) { pg8::EpiAct E{ACT}; run_gemm(lds, HN, D, (const bf16_t*)(ws + OFF_FFN), D, 2 * FF, D, E); SEAM(10); }
    if (IN(11)) { pg8::EpiBf16 E{FB, D}; run_gemm(lds, ACT, FF, (const bf16_t*)(ws + OFF_WD), FF, D, FF, E); SEAM(11); }
    if (IN(12)) { norm_rows(p, false, FB, 0.5f, p.in[I_F2POST], nullptr); }
}


#ifdef DBG_STOP
__global__ void dbg_dump(const unsigned short* src, float* out, size_t n) {
    for (size_t i = (size_t)blockIdx.x * 256 + threadIdx.x; i < n; i += (size_t)gridDim.x * 256) out[i] = __uint_as_float((unsigned)src[i] << 16);
}
#endif
extern "C" void kernel_launch(void* const* d_in, const int* in_sizes, int n_in, void* d_out, int out_size, void* d_ws, size_t ws_size, hipStream_t stream) {
    static int grid = 0;
    if (grid == 0) {
        if (n_in != 29 || ws_size < WS_NEED || out_size != NBATCH * SEQ * D) { fprintf(stderr, "kernel_launch: unexpected problem (n_in %d, ws %zu need %zu, out %d)\n", n_in, ws_size, (size_t)WS_NEED, out_size); grid = -1; return; }
        int dev = 0, cus = 0, per_cu = 0;
        hipGetDevice(&dev); hipDeviceGetAttribute(&cus, hipDeviceAttributeMultiprocessorCount, dev);
        if (hipFuncSetAttribute((const void*)fwd_kernel, hipFuncAttributeMaxDynamicSharedMemorySize, LDS_BYTES) != hipSuccess) { fprintf(stderr, "hipFuncSetAttribute failed\n"); grid = -1; return; }
        if (hipOccupancyMaxActiveBlocksPerMultiprocessor(&per_cu, (const void*)fwd_kernel, 512, LDS_BYTES) != hipSuccess || per_cu < 1) { fprintf(stderr, "occupancy query: %d\n", per_cu); per_cu = 1; }
        (void)hipGetLastError();
        grid = cus * 1;
    }
    if (grid < 0) return;
    Params p{};
    for (int i = 0; i < 29; ++i) p.in[i] = (const float*)d_in[i];
    p.out = (float*)d_out; p.ws = (unsigned char*)d_ws;
#if USE_GRID_SYNC
#ifndef CUTS
#define CUTS {0, NPHASE}
#endif
    const int cuts[] = CUTS;
    for (int li = 0; li + 1 < (int)(sizeof(cuts) / sizeof(int)); ++li) {
        p.ph_lo = cuts[li]; p.ph_hi = cuts[li + 1];
        if (hipMemsetAsync((char*)d_ws + OFF_CTL + 16384, 0, 16384, stream) != hipSuccess) { fprintf(stderr, "memset failed\n"); return; }
        void* args[] = {&p};
        hipError_t e = hipLaunchCooperativeKernel((const void*)fwd_kernel, dim3(grid), dim3(512), args, LDS_BYTES, stream);
        if (e != hipSuccess) fprintf(stderr, "cooperative launch failed: %s (grid %d)\n", hipGetErrorString(e), grid);
    }
#else
#ifdef DBG_STOP
    for (int ph = 0; ph <= DBG_STOP; ++ph) { p.ph_lo = ph; p.ph_hi = ph + 1; hipLaunchKernelGGL(fwd_kernel, dim3(grid), dim3(512), LDS_BYTES, stream, p); }
#ifdef DBG_DUMP_OFF
    hipLaunchKernelGGL(dbg_dump, dim3(2048), dim3(256), 0, stream, (const unsigned short*)((unsigned char*)d_ws + (size_t)(DBG_DUMP_OFF)), (float*)d_out, (size_t)NBATCH * SEQ * D);
#endif
#else
    for (int ph = 0; ph < NPHASE; ++ph) { p.ph_lo = ph; p.ph_hi = ph + 1; hipLaunchKernelGGL(fwd_kernel, dim3(grid), dim3(512), LDS_BYTES, stream, p); }
#endif
#endif
}
```

```cpp
#include <hip/hip_runtime.h>
#include <hip/hip_cooperative_groups.h>
#include <cstdio>
#include <cstdint>
namespace cg = cooperative_groups;

constexpr int D = 2048, NBATCH = 2, SEQ = 8192, MROWS = NBATCH * SEQ, FF = 5632;
constexpr int NIN = 8704;
constexpr float RMS_EPS = 1e-6f;
constexpr float LOG2E = 1.4426950408889634f;

constexpr size_t OFF_CTL = 0, OFF_RSQ = 65536, OFF_RSKV = 131072, OFF_KR = 262144;
constexpr size_t OFF_M_HN = 2621440, OFF_M_ACT = 2686976, OFF_M_F = 2867200, OFF_M_C = 2998272, OFF_M_HN2 = 3041536;
constexpr size_t OFF_M_DAQKV = 3145728, OFF_M_KVMLA = 3538944, OFF_M_KR = 3801088, OFF_M_END = 3809280;
constexpr size_t OFF_WIN = 8388608, OFF_WUQ = 44040192, OFF_WUKV = 46399488, OFF_WBDA = 48496640, OFF_WBMLA = 52690944, OFF_WOUT = 56885248;
constexpr size_t OFF_FFN = 65273856, OFF_WD = 111411200;
constexpr size_t OFF_HN = 134479872, OFF_F = 201588736, OFF_BIG = 335806464, WS_NEED = 530841600;
constexpr size_t OFF_CBUF = OFF_BIG + 100663296, OFF_QMLA = OFF_CBUF + 44040192;
constexpr int CP = 1344;

namespace pg8 {
#define PG8_LAS __attribute__((address_space(3)))
typedef unsigned short bf16_t;
typedef short bf16x8 __attribute__((ext_vector_type(8)));
typedef float f32x4 __attribute__((ext_vector_type(4)));
typedef unsigned u32x4 __attribute__((ext_vector_type(4)));
constexpr int BM = 256, BK = 64, HALF = 128, HTB = HALF * BK * 2  , STAGE_BYTES = 8 * HTB, NXCD = 8, WGM = 8;

__host__ __device__ __forceinline__ int lds_byte(int r, int c) { const int st = (r >> 4) * 2 + (c >> 5), rr = r & 15, cc = c & 31, ob = rr * 64 + cc * 2; return st * 1024 + (ob ^ (((ob >> 9) & 1) << 5)); }
__host__ __device__ __forceinline__ void stage_rc(int b, int& R, int& C) { const int st = b / 1024, sb = b % 1024, swz = sb ^ (((sb >> 9) & 1) << 5); R = (st >> 1) * 16 + swz / 64; C = (st & 1) * 32 + (swz % 64) / 2; }
__host__ __device__ __forceinline__ int perm32(int rho) { const int n = rho >> 4, i = rho & 15; return 8 * (i >> 2) + 4 * n + (i & 3); }

struct Unit { int pm, pn; };
struct Gemm { const bf16_t* A; const bf16_t* Bt; int M, N, K, lda, ldb; };

struct StaticOrder {
    int nM, nN, nwg, G, c;
    __host__ __device__ void init(int M, int N, int G_, int c_) { nM = M / BM; nN = N / BM; nwg = nM * nN; G = G_; c = c_; }
    __host__ __device__ bool next(int i, Unit& u) const {
        const long L = (long)i * G + c; if (L >= nwg) return false;
        int wgid = (int)L; { const int q = nwg / NXCD, r = nwg % NXCD, xcd = wgid % NXCD, off = wgid / NXCD; wgid = (xcd < r ? xcd * (q + 1) : r * (q + 1) + (xcd - r) * q) + off; }
        const int nig = WGM * nN, gid = wgid / nig, fm = gid * WGM, gsz = (nM - fm) < WGM ? (nM - fm) : WGM;
        u.pm = fm + ((wgid % nig) % gsz); u.pn = (wgid % nig) / gsz; return true;
    }
    __device__ __forceinline__ void a_ready(const Unit&) const {}
    __device__ __forceinline__ void done(const Unit&) const {}
};

__device__ __forceinline__ unsigned cvt_pk_bf16(float lo, float hi) { unsigned r; asm volatile("v_cvt_pk_bf16_f32 %0, %1, %2" : "=v"(r) : "v"(lo), "v"(hi)); return r; }
__device__ __forceinline__ float bf_lo(unsigned w) { return __uint_as_float(w << 16); }
__device__ __forceinline__ float bf_hi(unsigned w) { return __uint_as_float(w & 0xffff0000u); }
__device__ __forceinline__ float sigmoidf_(float x) { return __builtin_amdgcn_rcpf(1.f + __expf(-x)); }
typedef unsigned u32x2 __attribute__((ext_vector_type(2)));

struct EpiAct {
    static constexpr bool PERM = true, AFTER_DRAIN = false;
    bf16_t* O;
    __device__ __forceinline__ void operator()(const f32x4 (&acc)[2][2][4][2], const Unit& u, int wr, int wc, int fr, int fq) const {
        const int row0 = u.pm * BM + wr * 64 + fr, col0 = u.pn * 128 + wc * 32 + 8 * fq;
#pragma unroll
        for (int ai = 0; ai < 2; ++ai)
#pragma unroll
            for (int m = 0; m < 4; ++m) {
                float v[8];
#pragma unroll
                for (int n = 0; n < 2; ++n)
#pragma unroll
                    for (int j = 0; j < 4; ++j) { const float g = acc[ai][0][m][n][j], up = acc[ai][1][m][n][j]; v[n * 4 + j] = g * sigmoidf_(g) * up; }
                u32x4 w; w.x = cvt_pk_bf16(v[0], v[1]); w.y = cvt_pk_bf16(v[2], v[3]); w.z = cvt_pk_bf16(v[4], v[5]); w.w = cvt_pk_bf16(v[6], v[7]);
                *(u32x4*)(O + (size_t)(row0 + ai * HALF + m * 16) * FF + col0) = w;
            }
    }
};
struct EpiBf16 {
    static constexpr bool PERM = true, AFTER_DRAIN = false;
    bf16_t* O; int ldc;
    __device__ __forceinline__ void operator()(const f32x4 (&acc)[2][2][4][2], const Unit& u, int wr, int wc, int fr, int fq) const {
        const int row0 = u.pm * BM + wr * 64 + fr, col0 = u.pn * BM + wc * 32 + 8 * fq;
#pragma unroll
        for (int ai = 0; ai < 2; ++ai)
#pragma unroll
            for (int m = 0; m < 4; ++m) { bf16_t* rowp = O + (size_t)(row0 + ai * HALF + m * 16) * ldc + col0;
#pragma unroll
                for (int bj = 0; bj < 2; ++bj) { const f32x4 v0 = acc[ai][bj][m][0], v1 = acc[ai][bj][m][1];
                    u32x4 w; w.x = cvt_pk_bf16(v0[0], v0[1]); w.y = cvt_pk_bf16(v0[2], v0[3]); w.z = cvt_pk_bf16(v1[0], v1[1]); w.w = cvt_pk_bf16(v1[2], v1[3]);
                    *(u32x4*)(rowp + bj * HALF) = w; } }
    }
};
struct EpiF32 {
    static constexpr bool PERM = false, AFTER_DRAIN = false;
    float* O; int ldc;
    __device__ __forceinline__ void operator()(const f32x4 (&acc)[2][2][4][2], const Unit& u, int wr, int wc, int fr, int fq) const {
        const int row0 = u.pm * BM + wr * 64 + fr, col0 = u.pn * BM + wc * 32 + 4 * fq;
#pragma unroll
        for (int ai = 0; ai < 2; ++ai)
#pragma unroll
            for (int m = 0; m < 4; ++m) { float* rowp = O + (size_t)(row0 + ai * HALF + m * 16) * ldc + col0;
#pragma unroll
                for (int bj = 0; bj < 2; ++bj)
#pragma unroll
                    for (int n = 0; n < 2; ++n) *(f32x4*)(rowp + bj * HALF + n * 16) = acc[ai][bj][m][n]; }
    }
};
struct EpiInProj {
    static constexpr bool PERM = true, AFTER_DRAIN = false;
    bf16_t* gates; bf16_t* daqkv; bf16_t* cbuf; const float* bgate; float* rsq; float* rskv;
    __device__ __forceinline__ void operator()(const f32x4 (&acc)[2][2][4][2], const Unit& u, int wr, int wc, int fr, int fq) const {
        const int row0 = u.pm * BM + wr * 64 + fr, lc0 = wc * 32 + 8 * fq;
        const int pn = u.pn;
        {
            bf16_t* base; int ldc, cb; float* rs = nullptr;
            if (pn < 16) { base = gates; ldc = 4096; cb = pn * BM; }
            else if (pn < 28) { base = daqkv; ldc = 3072; cb = (pn - 16) * BM; }
            else { base = cbuf; ldc = CP; cb = (pn - 28) * BM; if (pn < 31) rs = rsq; else if (pn < 33) rs = rskv; }
            const bool last = (pn == 33);
#pragma unroll
            for (int ai = 0; ai < 2; ++ai)
#pragma unroll
                for (int m = 0; m < 4; ++m) { const int row = row0 + ai * HALF + m * 16; bf16_t* rowp = base + (size_t)row * ldc + cb + lc0; float ss = 0.f;
#pragma unroll
                    for (int bj = 0; bj < 2; ++bj) { const f32x4 v0 = acc[ai][bj][m][0], v1 = acc[ai][bj][m][1];
                        ss += (v0[0] * v0[0] + v0[1] * v0[1]) + (v0[2] * v0[2] + v0[3] * v0[3]) + (v1[0] * v1[0] + v1[1] * v1[1]) + (v1[2] * v1[2] + v1[3] * v1[3]);
                        u32x4 w; w.x = cvt_pk_bf16(v0[0], v0[1]); w.y = cvt_pk_bf16(v0[2], v0[3]); w.z = cvt_pk_bf16(v1[0], v1[1]); w.w = cvt_pk_bf16(v1[2], v1[3]);
                        if (!last || (bj == 0 && lc0 < 64)) *(u32x4*)(rowp + bj * HALF) = w; }
                    if (rs) { ss += __shfl_xor(ss, 16); ss += __shfl_xor(ss, 32); if (fq == 0) atomicAdd(rs + row, ss); } }
        }
    }
};
struct EpiRowScale {
    static constexpr bool PERM = true, AFTER_DRAIN = false;
    bf16_t* O; int ldc; const float* rs; float invk;
    __device__ __forceinline__ void operator()(const f32x4 (&acc)[2][2][4][2], const Unit& u, int wr, int wc, int fr, int fq) const {
        const int row0 = u.pm * BM + wr * 64 + fr, col0 = u.pn * BM + wc * 32 + 8 * fq;
#pragma unroll
        for (int ai = 0; ai < 2; ++ai)
#pragma unroll
            for (int m = 0; m < 4; ++m) { const int row = row0 + ai * HALF + m * 16; const float sc = __builtin_amdgcn_rsqf(__hip_atomic_load(rs + row, __ATOMIC_RELAXED, __HIP_MEMORY_SCOPE_AGENT) * invk + RMS_EPS); bf16_t* rowp = O + (size_t)row * ldc + col0;
#pragma unroll
                for (int bj = 0; bj < 2; ++bj) { const f32x4 v0 = acc[ai][bj][m][0] * sc, v1 = acc[ai][bj][m][1] * sc;
                    u32x4 w; w.x = cvt_pk_bf16(v0[0], v0[1]); w.y = cvt_pk_bf16(v0[2], v0[3]); w.z = cvt_pk_bf16(v1[0], v1[1]); w.w = cvt_pk_bf16(v1[2], v1[3]);
                    *(u32x4*)(rowp + bj * HALF) = w; } }
    }
};
template <int PASS> struct EpiGate {
    static constexpr int MID_K_UNUSED = 0;
    static constexpr bool PERM = true, AFTER_DRAIN = false;
    const bf16_t* gates; bf16_t* tmp; bf16_t* merged; const float* bgate;
    __device__ __forceinline__ void operator()(const f32x4 (&acc)[2][2][4][2], const Unit& u, int wr, int wc, int fr, int fq) const {
        const int row0 = u.pm * BM + wr * 64 + fr, col0 = u.pn * BM + wc * 32 + 8 * fq;
        f32x4 bb[2][2];
#pragma unroll
        for (int bj = 0; bj < 2; ++bj)
#pragma unroll
            for (int n = 0; n < 2; ++n) bb[bj][n] = *(const f32x4*)(bgate + PASS * 2048 + col0 + bj * HALF + 4 * n);
#pragma unroll
        for (int ai = 0; ai < 2; ++ai)
#pragma unroll
            for (int m = 0; m < 4; ++m) { const size_t row = (size_t)(row0 + ai * HALF + m * 16);
#pragma unroll
                for (int bj = 0; bj < 2; ++bj) { const int col = col0 + bj * HALF;
                    const u32x4 gw = __builtin_nontemporal_load((const u32x4*)(gates + row * 4096 + PASS * 2048 + col));
                    f32x4 v0 = acc[ai][bj][m][0], v1 = acc[ai][bj][m][1];
                    v0[0] *= sigmoidf_(bf_lo(gw.x) + bb[bj][0][0]); v0[1] *= sigmoidf_(bf_hi(gw.x) + bb[bj][0][1]); v0[2] *= sigmoidf_(bf_lo(gw.y) + bb[bj][0][2]); v0[3] *= sigmoidf_(bf_hi(gw.y) + bb[bj][0][3]);
                    v1[0] *= sigmoidf_(bf_lo(gw.z) + bb[bj][1][0]); v1[1] *= sigmoidf_(bf_hi(gw.z) + bb[bj][1][1]); v1[2] *= sigmoidf_(bf_lo(gw.w) + bb[bj][1][2]); v1[3] *= sigmoidf_(bf_hi(gw.w) + bb[bj][1][3]);
                    if (PASS == 1) { const u32x4 tw = *(const u32x4*)(tmp + row * D + col);
                        v0[0] += bf_lo(tw.x); v0[1] += bf_hi(tw.x); v0[2] += bf_lo(tw.y); v0[3] += bf_hi(tw.y); v1[0] += bf_lo(tw.z); v1[1] += bf_hi(tw.z); v1[2] += bf_lo(tw.w); v1[3] += bf_hi(tw.w); }
                    u32x4 w; w.x = cvt_pk_bf16(v0[0], v0[1]); w.y = cvt_pk_bf16(v0[2], v0[3]); w.z = cvt_pk_bf16(v1[0], v1[1]); w.w = cvt_pk_bf16(v1[2], v1[3]);
                    *(u32x4*)((PASS == 0 ? tmp : merged) + row * D + col) = w; } }
    }
};

template <class Epi, class Sched, bool ALIGN_EPI = false, bool SP2 = false>
__device__ __forceinline__ void gemm_phase(PG8_LAS unsigned char* lds, const Gemm g, const Sched& S, const Epi& E) {
    const int tid = threadIdx.x, wid = __builtin_amdgcn_readfirstlane(tid >> 6), lane = tid & 63, wr = wid >> 2, wc = wid & 3, fr = lane & 15, fq = lane >> 4;
    const int K = g.K, nt = K / BK;
    unsigned voffA[2], voffB[2];
#pragma unroll
    for (int i = 0; i < 2; ++i) { int R, C; stage_rc(tid * 16 + i * 8192, R, C); const int Rb = Epi::PERM ? ((R & ~31) + perm32(R & 31)) : R;
        voffA[i] = (unsigned)(R * g.lda + C) * 2u; voffB[i] = (unsigned)(Rb * g.ldb + C) * 2u; }
    const size_t kstep = (size_t)(BK * 2);
    const size_t hstepA = (size_t)HALF * g.lda * 2, hstepB = (size_t)HALF * g.ldb * 2;
    const size_t tstepA = 2 * hstepA, tstepB = 2 * hstepB;
    const unsigned ldsw = (unsigned)wid * 1024u;
    const int aoff = lds_byte(wr * 64 + fr, fq * 8), boff = lds_byte(wc * 32 + fr, fq * 8);
#define PG8_SA(b, h) (((b) * 2 + (h)) * HTB)
#define PG8_SB(b, h) ((4 + (b) * 2 + (h)) * HTB)
#define PG8_STAGE(bufoff, gbase, voff) do { _Pragma("unroll") for (int _i = 0; _i < 2; ++_i) \
        __builtin_amdgcn_global_load_lds((const unsigned*)((const char*)(gbase) + (voff)[_i]), (PG8_LAS unsigned*)(lds + (bufoff) + ldsw + _i * 8192), 16, 0, 0); } while (0)
#define PG8_LDA(dst, b, h) do { _Pragma("unroll") for (int m = 0; m < 4; ++m) _Pragma("unroll") for (int k = 0; k < 2; ++k) dst[m][k] = *(const PG8_LAS bf16x8*)(lds + PG8_SA(b, h) + aoff + m * 2048 + k * 1024); } while (0)
#define PG8_LDB(dst, b, h) do { _Pragma("unroll") for (int n = 0; n < 2; ++n) _Pragma("unroll") for (int k = 0; k < 2; ++k) dst[n][k] = *(const PG8_LAS bf16x8*)(lds + PG8_SB(b, h) + boff + n * 2048 + k * 1024); } while (0)
#define PG8_MMA(ai, bj, At, Bt) do { __builtin_amdgcn_s_setprio(1); _Pragma("unroll") for (int m = 0; m < 4; ++m) _Pragma("unroll") for (int n = 0; n < 2; ++n) _Pragma("unroll") for (int k = 0; k < 2; ++k) \
        acc[ai][bj][m][n] = __builtin_amdgcn_mfma_f32_16x16x32_bf16(Bt[n][k], At[m][k], acc[ai][bj][m][n], 0, 0, 0); __builtin_amdgcn_s_setprio(0); } while (0)
#define PG8_WAIT_V(n) asm volatile("s_waitcnt vmcnt(" #n ")" ::: "memory")
#define PG8_WAIT_L(n) asm volatile("s_waitcnt lgkmcnt(" #n ")" ::: "memory")
#define PG8_BAR __builtin_amdgcn_s_barrier()
#define PG8_SCHED __builtin_amdgcn_sched_barrier(0)
    Unit cur, nxt; int ui = 0;
    if (!S.next(0, cur)) return;
    f32x4 acc[2][2][4][2];
#pragma unroll
    for (int a = 0; a < 2; ++a)
#pragma unroll
        for (int b = 0; b < 2; ++b)
#pragma unroll
            for (int m = 0; m < 4; ++m)
#pragma unroll
                for (int n = 0; n < 2; ++n) acc[a][b][m][n] = (f32x4){0.f, 0.f, 0.f, 0.f};
    bf16x8 At[4][2], B0[2][2], B1[2][2];
    const char* cA = (const char*)g.A + (size_t)cur.pm * tstepA; const char* cB = (const char*)g.Bt + (size_t)cur.pn * tstepB;
    S.a_ready(cur);
    if constexpr (SP2) {
        PG8_STAGE(PG8_SB(0, 0), cB, voffB); PG8_STAGE(PG8_SB(0, 1), cB + hstepB, voffB); PG8_STAGE(PG8_SA(0, 0), cA, voffA); PG8_STAGE(PG8_SA(0, 1), cA + hstepA, voffA);
        if (wr == 1) PG8_BAR;
        PG8_WAIT_V(2); PG8_BAR;
        PG8_STAGE(PG8_SB(1, 0), cB + kstep, voffB); PG8_STAGE(PG8_SA(1, 0), cA + kstep, voffA); PG8_STAGE(PG8_SB(1, 1), cB + hstepB + kstep, voffB);
        PG8_WAIT_V(6); PG8_BAR;
    } else {
        PG8_STAGE(PG8_SB(0, 0), cB, voffB); PG8_STAGE(PG8_SA(0, 0), cA, voffA); PG8_STAGE(PG8_SB(0, 1), cB + hstepB, voffB); PG8_STAGE(PG8_SA(0, 1), cA + hstepA, voffA);
        if (wr == 1) PG8_BAR;
        PG8_WAIT_V(4); PG8_BAR;
        PG8_STAGE(PG8_SB(1, 0), cB + kstep, voffB); PG8_STAGE(PG8_SA(1, 0), cA + kstep, voffA); PG8_STAGE(PG8_SB(1, 1), cB + hstepB + kstep, voffB);
        PG8_WAIT_V(6); PG8_BAR;
    }
    for (;;) {
        const bool has_next = S.next(ui + 1, nxt);
        const char* nA = has_next ? (const char*)g.A + (size_t)nxt.pm * tstepA : cA; const char* nB = has_next ? (const char*)g.Bt + (size_t)nxt.pn * tstepB : cB;
        for (int t = 0; t < nt; t += 2) {
            const bool last = (t == nt - 2);
            const char* a1 = cA + (size_t)(t + 1) * kstep;
            const char* a2 = last ? nA : cA + (size_t)(t + 2) * kstep; const char* b2 = last ? nB : cB + (size_t)(t + 2) * kstep;
            const char* a3 = a2 + kstep; const char* b3 = b2 + kstep;
            if (last && has_next) S.a_ready(nxt);
            if constexpr (SP2) {
            PG8_LDB(B0, 0, 0); PG8_LDB(B1, 0, 1); PG8_SCHED; PG8_LDA(At, 0, 0); PG8_STAGE(PG8_SA(1, 1), a1 + hstepA, voffA);
            PG8_WAIT_V(8); PG8_WAIT_L(0); PG8_BAR; PG8_MMA(0, 0, At, B0); PG8_MMA(0, 1, At, B1); PG8_BAR; PG8_SCHED;
            PG8_LDA(At, 0, 1); PG8_STAGE(PG8_SB(0, 0), b2, voffB); PG8_STAGE(PG8_SB(0, 1), b2 + hstepB, voffB); PG8_STAGE(PG8_SA(0, 0), a2, voffA);
            PG8_WAIT_V(8); PG8_WAIT_L(0); PG8_BAR; PG8_MMA(1, 0, At, B0); PG8_MMA(1, 1, At, B1); PG8_BAR; PG8_SCHED;
            PG8_LDB(B0, 1, 0); PG8_LDB(B1, 1, 1); PG8_SCHED; PG8_LDA(At, 1, 0); PG8_STAGE(PG8_SA(0, 1), a2 + hstepA, voffA);
            PG8_WAIT_V(8); PG8_WAIT_L(0); PG8_BAR; PG8_MMA(0, 0, At, B0); PG8_MMA(0, 1, At, B1); PG8_BAR; PG8_SCHED;
            PG8_LDA(At, 1, 1); PG8_STAGE(PG8_SB(1, 0), b3, voffB); PG8_STAGE(PG8_SB(1, 1), b3 + hstepB, voffB); PG8_STAGE(PG8_SA(1, 0), a3, voffA);
            PG8_WAIT_V(8); PG8_WAIT_L(0); PG8_BAR; PG8_MMA(1, 0, At, B0); PG8_MMA(1, 1, At, B1); PG8_BAR; PG8_SCHED;
            } else {
            PG8_LDB(B0, 0, 0); PG8_SCHED; PG8_LDA(At, 0, 0); PG8_STAGE(PG8_SA(1, 1), a1 + hstepA, voffA);
            PG8_WAIT_L(8); PG8_BAR; PG8_WAIT_L(0); PG8_MMA(0, 0, At, B0); PG8_BAR; PG8_SCHED;
            PG8_LDB(B1, 0, 1); PG8_STAGE(PG8_SB(0, 0), b2, voffB);
            PG8_BAR; PG8_WAIT_L(0); PG8_MMA(0, 1, At, B1); PG8_BAR;
            PG8_LDA(At, 0, 1); PG8_STAGE(PG8_SA(0, 0), a2, voffA);
            PG8_BAR; PG8_WAIT_L(0); PG8_MMA(1, 0, At, B0); PG8_BAR; PG8_SCHED;
            PG8_STAGE(PG8_SB(0, 1), b2 + hstepB, voffB);
            PG8_WAIT_V(6); PG8_BAR; PG8_MMA(1, 1, At, B1); PG8_BAR;
            PG8_LDB(B0, 1, 0); PG8_SCHED; PG8_LDA(At, 1, 0); PG8_STAGE(PG8_SA(0, 1), a2 + hstepA, voffA);
            PG8_WAIT_L(8); PG8_BAR; PG8_WAIT_L(0); PG8_MMA(0, 0, At, B0); PG8_BAR; PG8_SCHED;
            PG8_LDB(B1, 1, 1); PG8_STAGE(PG8_SB(1, 0), b3, voffB);
            PG8_BAR; PG8_WAIT_L(0); PG8_MMA(0, 1, At, B1); PG8_BAR;
            PG8_LDA(At, 1, 1); PG8_STAGE(PG8_SA(1, 0), a3, voffA);
            PG8_BAR; PG8_WAIT_L(0); PG8_MMA(1, 0, At, B0); PG8_BAR; PG8_SCHED;
            PG8_STAGE(PG8_SB(1, 1), b3 + hstepB, voffB);
            PG8_WAIT_V(6); PG8_BAR; PG8_MMA(1, 1, At, B1); PG8_BAR;
            }
        }
        if constexpr (ALIGN_EPI) { if (wr == 0) PG8_BAR; }
        if constexpr (!Epi::AFTER_DRAIN) { E(acc, cur, wr, wc, fr, fq); S.done(cur); }
        if (!has_next) break;
#pragma unroll
        for (int a = 0; a < 2; ++a)
#pragma unroll
            for (int b = 0; b < 2; ++b)
#pragma unroll
                for (int m = 0; m < 4; ++m)
#pragma unroll
                    for (int n = 0; n < 2; ++n) acc[a][b][m][n] = (f32x4){0.f, 0.f, 0.f, 0.f};
        cur = nxt; cA = nA; cB = nB; ++ui;
        if constexpr (ALIGN_EPI) { if (wr == 1) PG8_BAR; }
    }
    PG8_WAIT_V(0);
    if constexpr (!ALIGN_EPI) { if (wr == 0) PG8_BAR; }
    PG8_BAR;
    if constexpr (Epi::AFTER_DRAIN) { E.fused(acc, cur, wr, wc, fr, fq, lds, wid, lane); S.done(cur); }
#undef PG8_SA
#undef PG8_SB
#undef PG8_STAGE
#undef PG8_LDA
#undef PG8_LDB
#undef PG8_MMA
#undef PG8_WAIT_V
#undef PG8_WAIT_L
#undef PG8_BAR
#undef PG8_SCHED
}
}
namespace att {
typedef unsigned short bf16_t;
typedef short bf16x8 __attribute__((ext_vector_type(8)));
typedef short s16x4 __attribute__((ext_vector_type(4)));
typedef float f32x16 __attribute__((ext_vector_type(16)));
typedef unsigned u32x4 __attribute__((ext_vector_type(4)));
typedef unsigned u32x2 __attribute__((ext_vector_type(2)));
#define ATT_LAS __attribute__((address_space(3)))
constexpr int VP = 320;
constexpr int KBUF_BYTES = 64 * 400, VBUF_BYTES = 64 * VP;
constexpr int L_K0 = 0, L_V0 = 2 * KBUF_BYTES, L_LUT = L_V0 + 3 * VBUF_BYTES, L_Q = L_LUT + 512;
__device__ __forceinline__ int crow(int r, int hi) { return (r & 3) + 8 * (r >> 2) + 4 * hi; }
__device__ __forceinline__ unsigned pk2(float lo, float hi) { unsigned r; asm volatile("v_cvt_pk_bf16_f32 %0, %1, %2" : "=v"(r) : "v"(lo), "v"(hi)); return r; }
__device__ __forceinline__ float bf2f(short s) { return __uint_as_float(((unsigned)(unsigned short)s) << 16); }
__device__ __forceinline__ s16x4 vtr(const ATT_LAS unsigned char* p) { typedef short v4i16_t __attribute__((ext_vector_type(4))); return __builtin_bit_cast(s16x4, __builtin_amdgcn_ds_read_tr16_b64_v4i16((ATT_LAS v4i16_t*)p)); }
__device__ __forceinline__ int t5_bucket(int n) {
    if (n < 16) return n;
    const float v = logf((float)n / 16.0f) / 2.0794415416798357f * 16.0f;
    int b = 16 + (int)v; return b < 31 ? b : 31;
}
__device__ __forceinline__ void rope_cs(int pos, int i, float& c, float& s) {
    const float inv = exp2f(-(float)i * (13.287712379549449f / 32.0f));
    const float ang = (float)pos * inv;
    const double t = (double)ang * 0.15915494309189535; const float fr = (float)(t - floor(t));
    s = __builtin_amdgcn_sinf(fr); c = __builtin_amdgcn_cosf(fr);
}

template <int DQK, bool BIAS, bool MLA>
__device__ __forceinline__ void flash_pass(ATT_LAS unsigned char* lds, const bf16_t* __restrict__ Qp, int ldq, const bf16_t* __restrict__ Kp, int ldk, const bf16_t* __restrict__ K2p,
                                           const bf16_t* __restrict__ Vp, int ldv, const bf16_t* __restrict__ Kmp, const bf16_t* __restrict__ K2mp, const bf16_t* __restrict__ Vmp, int Q0, float sc2, f32x16 (&o)[4]) {
    constexpr int KP = DQK * 2 + 16, NS = DQK / 16, KCH = DQK / 8;
    const int tid = threadIdx.x, lane = tid & 63, wid = __builtin_amdgcn_readfirstlane(tid >> 6), r32 = lane & 31, hi = lane >> 5;
    const int q0w = 64 + Q0 + 32 * wid, qpos = q0w + r32, qld = qpos - 64;
    const ATT_LAS float* lut = (const ATT_LAS float*)(lds + L_LUT);
    bf16x8 qf[NS];
#pragma unroll
    for (int s = 0; s < NS; ++s) qf[s] = *(const bf16x8*)(Qp + (size_t)qld * ldq + 16 * s + 8 * hi);
    if (MLA) {
#pragma unroll
        for (int s = 8; s < 10; ++s)
#pragma unroll
            for (int j = 0; j < 8; ++j) { float c, sn; rope_cs(qld + 16, 16 * (s - 8) + 8 * hi + j, c, sn);
                const float x1 = bf2f(qf[s][j]), x2 = bf2f(qf[s + 2][j]); const unsigned w = pk2(x1 * c - x2 * sn, x1 * sn + x2 * c);
                qf[s][j] = (short)(w & 0xffffu); qf[s + 2][j] = (short)(w >> 16); }
    }
#pragma unroll
    for (int c = 0; c < 4; ++c)
#pragma unroll
        for (int r = 0; r < 16; ++r) o[c][r] = 0.f;
    float mrun = -INFINITY, lsum = 0.f;
    const int NT = Q0 / 64 + 5;
    constexpr int KCPR = KCH + 1, NKI = KCPR, NVI = 20;
    constexpr int NPW = (NKI + NVI + 7) / 8;
    unsigned poff[NPW];
#pragma unroll
    for (int i = 0; i < NPW; ++i) { const int pc = wid + 8 * i;
        if (pc < NKI) { const int L = 64 * pc + lane, row = L / KCPR, ch = L - row * KCPR;
            poff[i] = (MLA && ch >= 16 && ch < 24) ? (0x80000000u | (unsigned)(row * 64 + 8 * (ch - 16)) * 2u) : (unsigned)(row * ldk + 8 * (ch < (MLA ? 16 : KCH) ? ch : 0)) * 2u; }
        else { const int L = 64 * (pc - NKI) + lane, row = L / 20, ch = L - row * 20; poff[i] = (unsigned)(row * ldv + 8 * (ch < 16 ? ch : 0)) * 2u; } }
    auto issue = [&](int kt, int kslot, int vslot) __attribute__((always_inline)) {
        const char* kbase = (const char*)(kt == 0 ? Kmp : Kp + (size_t)(64 * (kt - 1)) * ldk);
        const char* vbase = (const char*)(kt == 0 ? Vmp : Vp + (size_t)(64 * (kt - 1)) * ldv);
        const char* k2base = MLA ? (const char*)(kt == 0 ? K2mp : K2p + (size_t)(64 * (kt - 1)) * 64) : nullptr;
#pragma unroll
        for (int i = 0; i < NPW; ++i) { const int pc = wid + 8 * i;
            if (pc < NKI) { const char* src = (MLA && (poff[i] >> 31)) ? k2base + (poff[i] & 0x7fffffffu) : kbase + poff[i];
                __builtin_amdgcn_global_load_lds((const unsigned*)src, (ATT_LAS unsigned*)(lds + L_K0 + kslot * KBUF_BYTES + pc * 1024), 16, 0, 0); }
            else if (pc < NKI + NVI) __builtin_amdgcn_global_load_lds((const unsigned*)(vbase + poff[i]), (ATT_LAS unsigned*)(lds + L_V0 + vslot * VBUF_BYTES + (pc - NKI) * 1024), 16, 0, 0); }
    };
    const int vlane = (4 * hi + ((lane & 15) >> 2)) * VP + (16 * ((lane >> 4) & 1) + 4 * (lane & 3)) * 2;
    u32x4 pw[4];
    auto qk_softmax = [&](int kt, int kslot) __attribute__((always_inline)) {
        const int k0 = 64 * kt;
        f32x16 p0, p1;
#pragma unroll
        for (int r = 0; r < 16; ++r) { p0[r] = 0.f; p1[r] = 0.f; }
        const ATT_LAS unsigned char* kb = lds + L_K0 + kslot * KBUF_BYTES + r32 * KP + hi * 16;
#pragma unroll
        for (int s = 0; s < NS; ++s) { const bf16x8 a0 = *(const ATT_LAS bf16x8*)(kb + s * 32), a1 = *(const ATT_LAS bf16x8*)(kb + 32 * KP + s * 32);
            p0 = __builtin_amdgcn_mfma_f32_32x32x16_bf16(a0, qf[s], p0, 0, 0, 0); p1 = __builtin_amdgcn_mfma_f32_32x32x16_bf16(a1, qf[s], p1, 0, 0, 0); }
        const bool edge = (k0 + 63 > q0w) || (kt == 0) || (BIAS && (q0w - (k0 + 63) < 113));
        float SC = sc2, C0 = BIAS ? lut[127] : 0.f;
        if (edge) {
#pragma unroll
            for (int r = 0; r < 16; ++r) {
                const int kp0 = k0 + crow(r, hi), kp1 = kp0 + 32; const int rel0 = qpos - kp0, rel1 = qpos - kp1;
                float s0 = p0[r] * sc2, s1 = p1[r] * sc2;
                if (BIAS) { s0 += lut[rel0 < 0 ? 0 : (rel0 > 127 ? 127 : rel0)]; s1 += lut[rel1 < 0 ? 0 : (rel1 > 127 ? 127 : rel1)]; }
                p0[r] = (rel0 >= 0 && kp0 >= 48) ? s0 : -INFINITY; p1[r] = (rel1 >= 0 && kp1 >= 48) ? s1 : -INFINITY;
            }
            SC = 1.f; C0 = 0.f;
        }
        float mx = fmaxf(p0[0], p1[0]);
#pragma unroll
        for (int r = 1; r < 16; ++r) mx = fmaxf(mx, fmaxf(p0[r], p1[r]));
        mx = fmaxf(mx, __shfl_xor(mx, 32)) * SC + C0;
        const float mnew = (mx > mrun + 8.0f) ? mx : mrun, muse = (mnew == -INFINITY) ? 0.f : mnew;
        const float alpha = __builtin_amdgcn_exp2f(mrun - muse); mrun = mnew;
        const float c0 = C0 - muse; float ps = 0.f;
#pragma unroll
        for (int r = 0; r < 16; ++r) { p0[r] = __builtin_amdgcn_exp2f(__builtin_fmaf(p0[r], SC, c0)); p1[r] = __builtin_amdgcn_exp2f(__builtin_fmaf(p1[r], SC, c0)); ps += p0[r] + p1[r]; }
        lsum = lsum * alpha + ps;
        if (__any(alpha != 1.f)) {
#pragma unroll
            for (int c = 0; c < 4; ++c)
#pragma unroll
                for (int r = 0; r < 16; ++r) o[c][r] *= alpha;
        }
#pragma unroll
        for (int s2 = 0; s2 < 2; ++s2) {
            pw[s2] = (u32x4){pk2(p0[8 * s2 + 0], p0[8 * s2 + 1]), pk2(p0[8 * s2 + 2], p0[8 * s2 + 3]), pk2(p0[8 * s2 + 4], p0[8 * s2 + 5]), pk2(p0[8 * s2 + 6], p0[8 * s2 + 7])};
            pw[2 + s2] = (u32x4){pk2(p1[8 * s2 + 0], p1[8 * s2 + 1]), pk2(p1[8 * s2 + 2], p1[8 * s2 + 3]), pk2(p1[8 * s2 + 4], p1[8 * s2 + 5]), pk2(p1[8 * s2 + 6], p1[8 * s2 + 7])};
        }
    };
    auto pv = [&](int vslot) __attribute__((always_inline)) {
        const ATT_LAS unsigned char* vb = lds + L_V0 + vslot * VBUF_BYTES + vlane;
#pragma unroll
        for (int sl = 0; sl < 4; ++sl) {
            const bf16x8 pf = __builtin_bit_cast(bf16x8, pw[sl]);
#pragma unroll
            for (int c = 0; c < 4; ++c) {
                const s16x4 lo = vtr(vb + (16 * sl) * VP + c * 64), hh = vtr(vb + (16 * sl + 8) * VP + c * 64);
                const bf16x8 vf = (bf16x8){lo[0], lo[1], lo[2], lo[3], hh[0], hh[1], hh[2], hh[3]};
                o[c] = __builtin_amdgcn_mfma_f32_32x32x16_bf16(vf, pf, o[c], 0, 0, 0);
            }
        }
    };
    constexpr bool SKEW = false;
    const bool late = SKEW && !MLA && wid >= 4;
    issue(0, 0, 0); asm volatile("s_waitcnt vmcnt(0)" ::: "memory"); __syncthreads();
    int vs_prev = 2, vs_cur = 0, vs_next = 1;
    for (int kt = 0; kt < NT + (SKEW && !MLA ? 1 : 0); ++kt) {
        if (kt + 1 < NT) issue(kt + 1, (kt + 1) & 1, vs_next);
        const bool act = kt < NT && 64 * kt <= q0w + 31;
        if (late && kt > 0 && 64 * (kt - 1) <= q0w + 31) pv(vs_prev);
        if (act) qk_softmax(kt, kt & 1);
        if (!late && act) pv(vs_cur);
        asm volatile("s_waitcnt vmcnt(0)" ::: "memory"); __syncthreads();
        const int t = vs_prev; vs_prev = vs_cur; vs_cur = vs_next; vs_next = t;
    }
    const float lt = lsum + __shfl_xor(lsum, 32);
    const float inv = lt > 0.f ? 1.f / lt : 0.f;
#pragma unroll
    for (int c = 0; c < 4; ++c)
#pragma unroll
        for (int r = 0; r < 16; ++r) o[c][r] *= inv;
}

struct AttnArgs {
    const bf16_t* daqkv; const bf16_t* qmla; const bf16_t* kvmla; const bf16_t* kr; const bf16_t* m_daqkv; const bf16_t* m_kvmla; const bf16_t* m_kr; bf16_t* yda; bf16_t* ymla;
    const float* table; const float* subg; const float* lq1; const float* lk1; const float* lq2; const float* lk2; int* counter;
};
template <int TYPE> __device__ __forceinline__ void attn_units(ATT_LAS unsigned char* lds, const AttnArgs& A) {
    const int tid = threadIdx.x, lane = tid & 63, wid = __builtin_amdgcn_readfirstlane(tid >> 6), r32 = lane & 31, hi = lane >> 5;
    ATT_LAS int* qslot = (ATT_LAS int*)(lds + L_Q);
    ATT_LAS float* lut = (ATT_LAS float*)(lds + L_LUT);
    constexpr int NJ = 32, TOTAL = NJ * 16;
    for (;;) {
        __syncthreads();
        if (tid == 0) *qslot = atomicAdd(A.counter + TYPE, 1);
        __syncthreads();
        const int u = *qslot;
        if (u >= TOTAL) break;
        const int j = NJ - 1 - (u >> 4), rem = u & 15, b = rem >> 3, h = rem & 7;
        const int Q0 = 256 * j; const size_t brow = (size_t)b * SEQ;
        const int qpos = Q0 + 32 * wid + r32;
        f32x16 o[4];
        if (TYPE == 0) {
            float lam;
            { float a = A.lq1[lane] * A.lk1[lane], bb = A.lq2[lane] * A.lk2[lane];
#pragma unroll
              for (int off = 1; off < 64; off <<= 1) { a += __shfl_xor(a, off); bb += __shfl_xor(bb, off); }
              lam = expf(a) - expf(bb) + 0.2f; }
            if (tid < 128) lut[tid] = A.table[t5_bucket(tid) * 8 + h] * LOG2E;
            bf16_t* orow = A.yda + (brow + qpos) * 1024 + h * 128;
#pragma unroll
            for (int comp = 0; comp < 2; ++comp) {
                const bf16_t* base = A.daqkv + brow * 3072 + h * 128;
                const bf16_t* mb = A.m_daqkv + h * 128;
                flash_pass<64, true, false>(lds, base + comp * 64, 3072, base + 1024 + comp * 64, 3072, nullptr, base + 2048, 3072, mb + 1024 + comp * 64, nullptr, mb + 2048, Q0, 0.125f * LOG2E, o);
                if (comp == 0) {
#pragma unroll
                    for (int c = 0; c < 4; ++c)
#pragma unroll
                        for (int g4 = 0; g4 < 4; ++g4) { u32x2 w; w.x = pk2(o[c][4 * g4 + 0], o[c][4 * g4 + 1]); w.y = pk2(o[c][4 * g4 + 2], o[c][4 * g4 + 3]); *(u32x2*)(orow + 32 * c + 8 * g4 + 4 * hi) = w; }
                }
            }
            float ss = 0.f;
#pragma unroll
            for (int c = 0; c < 4; ++c)
#pragma unroll
                for (int g4 = 0; g4 < 4; ++g4) { const u32x2 w = *(const u32x2*)(orow + 32 * c + 8 * g4 + 4 * hi);
                    const float y0 = __uint_as_float(w.x << 16) - lam * o[c][4 * g4 + 0], y1 = __uint_as_float(w.x & 0xffff0000u) - lam * o[c][4 * g4 + 1];
                    const float y2 = __uint_as_float(w.y << 16) - lam * o[c][4 * g4 + 2], y3 = __uint_as_float(w.y & 0xffff0000u) - lam * o[c][4 * g4 + 3];
                    o[c][4 * g4 + 0] = y0; o[c][4 * g4 + 1] = y1; o[c][4 * g4 + 2] = y2; o[c][4 * g4 + 3] = y3; ss += (y0 * y0 + y1 * y1) + (y2 * y2 + y3 * y3); }
            ss += __shfl_xor(ss, 32);
            const float rstd = __builtin_amdgcn_rsqf(ss * (1.f / 128.f) + RMS_EPS) * 0.8f;
            {
#pragma unroll
                for (int c = 0; c < 4; ++c)
#pragma unroll
                    for (int g4 = 0; g4 < 4; ++g4) { const int d0 = 32 * c + 8 * g4 + 4 * hi; const float4 gv = *(const float4*)(A.subg + d0);
                        u32x2 w; w.x = pk2(o[c][4 * g4 + 0] * rstd * gv.x, o[c][4 * g4 + 1] * rstd * gv.y); w.y = pk2(o[c][4 * g4 + 2] * rstd * gv.z, o[c][4 * g4 + 3] * rstd * gv.w);
                        *(u32x2*)(orow + d0) = w; }
            }
        } else {
            flash_pass<192, false, true>(lds, A.qmla + brow * 1536 + h * 192, 1536, A.kvmla + brow * 2048 + h * 256, 2048, A.kr + brow * 64, A.kvmla + brow * 2048 + h * 256 + 128, 2048,
                                         A.m_kvmla + h * 256, A.m_kr, A.m_kvmla + h * 256 + 128, Q0,
                                         0.07216878364870322f * LOG2E, o);
            {
                bf16_t* orow = A.ymla + (brow + qpos) * 1024 + h * 128;
#pragma unroll
                for (int c = 0; c < 4; ++c)
#pragma unroll
                    for (int g4 = 0; g4 < 4; ++g4) { const int d0 = 32 * c + 8 * g4 + 4 * hi;
                        u32x2 w; w.x = pk2(o[c][4 * g4 + 0], o[c][4 * g4 + 1]); w.y = pk2(o[c][4 * g4 + 2], o[c][4 * g4 + 3]);
                        *(u32x2*)(orow + d0) = w; }
            }
        }
    }
}
__device__ __forceinline__ void attn_phase(ATT_LAS unsigned char* lds, const AttnArgs& A) {
#ifndef ATT_TYPES
#define ATT_TYPES 3
#endif
    if (ATT_TYPES & 1) attn_units<0>(lds, A);
    if (ATT_TYPES & 2) attn_units<1>(lds, A);
}
}
typedef unsigned short bf16_t;
typedef float f32x4 __attribute__((ext_vector_type(4)));
typedef unsigned u32x4 __attribute__((ext_vector_type(4)));
typedef unsigned u32x2 __attribute__((ext_vector_type(2)));
#define LAS __attribute__((address_space(3)))

#define XB_TMO      128
#define XB_XCNT(j)  (256  + 64 * (j))
#define XB_XSUB(j)  (1280 + 64 * (j))
#define XB_XGEN(j)  (2304 + 64 * (j))
#define XB_TOP      3328
#define XB_TOPGEN   3392
#define XCD_BAR_WORDS 3456
#define XB_SPIN_CAP (1u << 18)

__device__ __forceinline__ unsigned xb_ld(unsigned* p)              { return __hip_atomic_load(p, __ATOMIC_RELAXED, __HIP_MEMORY_SCOPE_AGENT); }
__device__ __forceinline__ unsigned xb_add(unsigned* p, unsigned v) { return __hip_atomic_fetch_add(p, v, __ATOMIC_RELAXED, __HIP_MEMORY_SCOPE_AGENT); }
__device__ __forceinline__ unsigned xb_xcc_id() { return (unsigned)__builtin_amdgcn_s_getreg((3 << 11) | 20) & 0xFu; }
#define XB_SPIN(cond, bar) do { unsigned _sp = 0; while (cond) { __builtin_amdgcn_s_sleep(1); \
    if ((++_sp & 255u) == 0u) { if (xb_ld(&(bar)[XB_TMO])) break; if (_sp > XB_SPIN_CAP) { atomicAdd(&(bar)[XB_TMO], 1u); break; } } } } while (0)

struct XcdBarrier {
    unsigned* bar; unsigned x;
    volatile LAS unsigned* st;
};

__device__ __forceinline__ XcdBarrier xcd_barrier_post(unsigned* bar, volatile LAS unsigned* st) {
    XcdBarrier b; b.bar = bar; b.x = xb_xcc_id(); b.st = st;
    if (threadIdx.x == 0) (void)xb_add(&bar[XB_XCNT(b.x)], 1u);
    return b;
}
__device__ __forceinline__ void xcd_barrier_complete(unsigned* bar, unsigned x, unsigned& nloc, unsigned& nx) {
    const unsigned G = gridDim.x * gridDim.y * gridDim.z;
    unsigned sum, cnt, mine, sp = 0u;
    for (;;) {
        sum = 0u; cnt = 0u; mine = 0u;
#pragma unroll
        for (unsigned j = 0; j < 16; ++j) { const unsigned c = xb_ld(&bar[XB_XCNT(j)]); sum += c; cnt += (c > 0u) ? 1u : 0u; mine = (j == x) ? c : mine; }
        if (sum == G) break;
        __builtin_amdgcn_s_sleep(1);
        if ((++sp & 255u) == 0u) { if (xb_ld(&bar[XB_TMO])) break; if (sp > XB_SPIN_CAP) { atomicAdd(&bar[XB_TMO], 1u); break; } }
    }
    nloc = mine > 0u ? mine : 1u; nx = cnt > 0u ? cnt : 1u;
}

__device__ __forceinline__ void xcd_barrier(const XcdBarrier& b) {
    asm volatile("s_waitcnt vmcnt(0)" ::: "memory");
    __syncthreads();
    if (threadIdx.x == 0) {
        unsigned* bar = b.bar;
        __builtin_amdgcn_s_waitcnt(0);
        unsigned nloc = b.st[0], nx = b.st[1];
        if (nloc == 0u) { xcd_barrier_complete(bar, b.x, nloc, nx); b.st[0] = nloc; b.st[1] = nx; }
        const unsigned old = xb_add(&bar[XB_XSUB(b.x)], 1u);
        const unsigned gen = old / nloc;
        if (old + 1u == (gen + 1u) * nloc) {
            __builtin_amdgcn_fence(__ATOMIC_RELEASE, "agent");
            asm volatile("s_waitcnt vmcnt(0)" ::: "memory");
            const unsigned og = xb_add(&bar[XB_TOP], 1u);
            const unsigned tg = og / nx;
            if (og + 1u == (tg + 1u) * nx) xb_add(&bar[XB_TOPGEN], 1u);
            else XB_SPIN(xb_ld(&bar[XB_TOPGEN]) == tg, bar);
            __builtin_amdgcn_fence(__ATOMIC_ACQUIRE, "agent");
            xb_add(&bar[XB_XGEN(b.x)], 1u);
            asm volatile("s_waitcnt vmcnt(0)" ::: "memory");
        } else {
            XB_SPIN(xb_ld(&bar[XB_XGEN(b.x)]) == gen, bar);
            __builtin_amdgcn_fence(__ATOMIC_ACQUIRE, "agent");
            asm volatile("s_waitcnt vmcnt(0)" ::: "memory");
        }
    }
    __syncthreads();
}


struct Params {
    const float* in[29];
    float* out; unsigned char* ws;
    int ph_lo, ph_hi;
};
enum { I_X = 0, I_META, I_TABLE, I_F1PRE, I_F1POST, I_F1G, I_F1U, I_F1D, I_MIXPRE, I_MIXPOST, I_WIN, I_BGATE, I_LQ1, I_LK1, I_LQ2, I_LK2, I_SUBG, I_QNG, I_KVNG, I_WUQ, I_WUKV,
       I_WBDA, I_WBMLA, I_WOUT, I_F2PRE, I_F2POST, I_F2G, I_F2U, I_F2D };

__device__ __forceinline__ float wave_sum(float v) {
#pragma unroll
    for (int o = 1; o < 64; o <<= 1) v += __shfl_xor(v, o);
    return v;
}
__device__ __forceinline__ unsigned pkbf(float lo, float hi) { unsigned r; asm volatile("v_cvt_pk_bf16_f32 %0, %1, %2" : "=v"(r) : "v"(lo), "v"(hi)); return r; }

struct CvtJob { const float* src; bf16_t* dst; const float* kscale; int K, N, mode; };
__device__ __forceinline__ int cvt_maprow(int mode, int n) {
    if (mode == 1) return 256 * (n >> 7) + (n & 127);
    if (mode == 2) return 256 * (n >> 7) + 128 + (n & 127);
    if (mode == 3) return n < 4416 ? n + 4096 : n - 4416;
    return n;
}
__device__ __forceinline__ void cvt_load(const CvtJob& jb, int t, f32x4 (&a)[8]) {
    const int lane = threadIdx.x & 63, nbn = jb.N >> 5, kb = t / nbn, nb = t - kb * nbn, k0 = kb * 64, n0 = nb * 32, rr = lane >> 3, c4 = (lane & 7) * 4;
#pragma unroll
    for (int i = 0; i < 8; ++i) a[i] = __builtin_nontemporal_load((const f32x4*)(jb.src + (size_t)(k0 + 8 * i + rr) * jb.N + n0 + c4));
}
__device__ __forceinline__ void cvt_finish(const CvtJob& jb, int t, const f32x4 (&a)[8], LAS float* scr) {
    const int lane = threadIdx.x & 63, nbn = jb.N >> 5, kb = t / nbn, nb = t - kb * nbn, k0 = kb * 64, n0 = nb * 32;
    { const int rr = lane >> 3, c4 = (lane & 7) * 4;
#pragma unroll
      for (int i = 0; i < 8; ++i) { const int k = 8 * i + rr; const float sc = jb.kscale ? jb.kscale[k0 + k] : 1.f;
          LAS float* d = scr + k * 33 + c4; d[0] = a[i][0] * sc; d[1] = a[i][1] * sc; d[2] = a[i][2] * sc; d[3] = a[i][3] * sc; } }
    asm volatile("s_waitcnt lgkmcnt(0)" ::: "memory");
    { const int kc = (lane & 7) * 8;
#pragma unroll
      for (int j = 0; j < 4; ++j) { const int nn = (lane >> 3) + 8 * j; const LAS float* s = scr + kc * 33 + nn;
          u32x4 w; w.x = pkbf(s[0], s[33]); w.y = pkbf(s[66], s[99]); w.z = pkbf(s[132], s[165]); w.w = pkbf(s[198], s[231]);
          *(u32x4*)(jb.dst + (size_t)cvt_maprow(jb.mode, n0 + nn) * jb.K + k0 + kc) = w; } }
    asm volatile("s_waitcnt lgkmcnt(0)" ::: "memory");
}
__device__ __forceinline__ CvtJob cvt_job(const Params& p, int j) {
    unsigned char* ws = p.ws; CvtJob r;
    switch (j) {
    case 0: r = CvtJob{p.in[I_WIN], (bf16_t*)(ws + OFF_WIN), nullptr, 2048, 8512, 3}; break;
    case 1: r = CvtJob{p.in[I_WUQ], (bf16_t*)(ws + OFF_WUQ), p.in[I_QNG], 768, 1536, 0}; break;
    case 2: r = CvtJob{p.in[I_WUKV], (bf16_t*)(ws + OFF_WUKV), p.in[I_KVNG], 512, 2048, 0}; break;
    case 3: r = CvtJob{p.in[I_WBDA], (bf16_t*)(ws + OFF_WBDA), nullptr, 1024, 2048, 0}; break;
    case 4: r = CvtJob{p.in[I_WBMLA], (bf16_t*)(ws + OFF_WBMLA), nullptr, 1024, 2048, 0}; break;
    case 5: r = CvtJob{p.in[I_WOUT], (bf16_t*)(ws + OFF_WOUT), nullptr, 2048, 2048, 0}; break;
    case 6: r = CvtJob{p.in[I_F1G], (bf16_t*)(ws + OFF_FFN), nullptr, 2048, 5632, 1}; break;
    case 7: r = CvtJob{p.in[I_F1U], (bf16_t*)(ws + OFF_FFN), nullptr, 2048, 5632, 2}; break;
    case 8: r = CvtJob{p.in[I_F1D], (bf16_t*)(ws + OFF_WD), nullptr, 5632, 2048, 0}; break;
    case 9: r = CvtJob{p.in[I_F2G], (bf16_t*)(ws + OFF_FFN), nullptr, 2048, 5632, 1}; break;
    case 10: r = CvtJob{p.in[I_F2U], (bf16_t*)(ws + OFF_FFN), nullptr, 2048, 5632, 2}; break;
    default: r = CvtJob{p.in[I_F2D], (bf16_t*)(ws + OFF_WD), nullptr, 5632, 2048, 0}; break;
    }
    return r;
}
template <int JLO, int JHI> __device__ __forceinline__ void cvt_jobs(const Params& p, LAS float* tile) {
    const int wid = threadIdx.x >> 6, nw = (int)gridDim.x * 8, gw = (int)blockIdx.x * 8 + wid;
    LAS float* scr = tile + wid * (64 * 33);
    int base = 0;
#pragma unroll
    for (int j = JLO; j < JHI; ++j) {
        const CvtJob jb = cvt_job(p, j); const int nt = (jb.K >> 6) * (jb.N >> 5);
        int t = (gw - base % nw + nw) % nw;
        f32x4 ra[8], rb[8];
        if (t < nt) cvt_load(jb, t, ra);
        for (; t < nt; t += 2 * nw) {
            const int t1 = t + nw, t2 = t + 2 * nw;
            if (t1 < nt) cvt_load(jb, t1, rb);
            cvt_finish(jb, t, ra, scr);
            if (t1 < nt) { if (t2 < nt) cvt_load(jb, t2, ra); cvt_finish(jb, t1, rb, scr); }
        }
        base += nt;
    }
    __syncthreads();
}

__device__ __forceinline__ void norm_rows(const Params& p, bool src_input, const bf16_t* f, float coef, const float* gpost, const float* gnext) {
    const int lane = threadIdx.x & 63, wid = threadIdx.x >> 6;
    bf16_t* HN = (bf16_t*)(p.ws + OFF_HN);
    for (int row = blockIdx.x * 8 + wid; row < MROWS; row += gridDim.x * 8) {
        const float* hsrc = (src_input ? p.in[I_X] : p.out) + (size_t)row * D;
        f32x4 hv[8];
#pragma unroll
        for (int i = 0; i < 8; ++i) hv[i] = __builtin_nontemporal_load((const f32x4*)hsrc + lane + 64 * i);
        if (f) {
            f32x4 fv[8]; float ss = 0.f;
#pragma unroll
            for (int i = 0; i < 8; ++i) { const u32x2 w = __builtin_nontemporal_load((const u32x2*)(f + (size_t)row * D) + lane + 64 * i); fv[i] = (f32x4){__uint_as_float(w.x << 16), __uint_as_float(w.x & 0xffff0000u), __uint_as_float(w.y << 16), __uint_as_float(w.y & 0xffff0000u)};
                ss += (fv[i][0] * fv[i][0] + fv[i][1] * fv[i][1]) + (fv[i][2] * fv[i][2] + fv[i][3] * fv[i][3]); }
            const float r = coef * __builtin_amdgcn_rsqf(wave_sum(ss) * (1.f / D) + RMS_EPS);
#pragma unroll
            for (int i = 0; i < 8; ++i) { const f32x4 g = ((const f32x4*)gpost)[lane + 64 * i]; hv[i] = hv[i] + fv[i] * g * r; }
            float* hd = p.out + (size_t)row * D;
#pragma unroll
            for (int i = 0; i < 8; ++i) { if (gnext) ((f32x4*)hd)[lane + 64 * i] = hv[i]; else __builtin_nontemporal_store(hv[i], (f32x4*)hd + lane + 64 * i); }
        }
        if (gnext) {
            float ss = 0.f;
#pragma unroll
            for (int i = 0; i < 8; ++i) ss += (hv[i][0] * hv[i][0] + hv[i][1] * hv[i][1]) + (hv[i][2] * hv[i][2] + hv[i][3] * hv[i][3]);
            const float r = __builtin_amdgcn_rsqf(wave_sum(ss) * (1.f / D) + RMS_EPS);
            u32x2* o = (u32x2*)(HN + (size_t)row * D);
#pragma unroll
            for (int i = 0; i < 8; ++i) { const f32x4 g = ((const f32x4*)gnext)[lane + 64 * i]; const f32x4 v = hv[i] * g * r; o[lane + 64 * i] = (u32x2){pkbf(v[0], v[1]), pkbf(v[2], v[3])}; }
        }
    }
}
__device__ __forceinline__ void norm_meta(const Params& p, const float* f, const float* gpost, const float* gnext, bf16_t* HNM) {
    if (blockIdx.x != gridDim.x - 1) return;
    const int lane = threadIdx.x & 63, wid = threadIdx.x >> 6;
    for (int row = wid; row < 16; row += 8) {
        f32x4 hv[8];
#pragma unroll
        for (int i = 0; i < 8; ++i) hv[i] = ((const f32x4*)(p.in[I_META] + (size_t)row * D))[lane + 64 * i];
        if (f) {
            f32x4 fv[8]; float ss = 0.f;
#pragma unroll
            for (int i = 0; i < 8; ++i) { fv[i] = ((const f32x4*)(f + (size_t)row * D))[lane + 64 * i]; ss += (fv[i][0] * fv[i][0] + fv[i][1] * fv[i][1]) + (fv[i][2] * fv[i][2] + fv[i][3] * fv[i][3]); }
            const float r = 0.5f * __builtin_amdgcn_rsqf(wave_sum(ss) * (1.f / D) + RMS_EPS);
#pragma unroll
            for (int i = 0; i < 8; ++i) { const f32x4 g = ((const f32x4*)gpost)[lane + 64 * i]; hv[i] = hv[i] + fv[i] * g * r; }
        }
        float ss = 0.f;
#pragma unroll
        for (int i = 0; i < 8; ++i) ss += (hv[i][0] * hv[i][0] + hv[i][1] * hv[i][1]) + (hv[i][2] * hv[i][2] + hv[i][3] * hv[i][3]);
        const float r = __builtin_amdgcn_rsqf(wave_sum(ss) * (1.f / D) + RMS_EPS);
        u32x2* o = (u32x2*)(HNM + (size_t)row * D);
#pragma unroll
        for (int i = 0; i < 8; ++i) { const f32x4 g = ((const f32x4*)gnext)[lane + 64 * i]; const f32x4 v = hv[i] * g * r; o[lane + 64 * i] = (u32x2){pkbf(v[0], v[1]), pkbf(v[2], v[3])}; }
    }
}
__device__ __forceinline__ void rope_k_rows(const Params& p) {
    const bf16_t* cb = (const bf16_t*)(p.ws + OFF_CBUF); bf16_t* kr = (bf16_t*)(p.ws + OFF_KR);
    const bf16_t* cm = (const bf16_t*)(p.ws + OFF_M_C); bf16_t* krm = (bf16_t*)(p.ws + OFF_M_KR);
    const int total = (MROWS + 16) * 32;
    for (int idx = blockIdx.x * 512 + threadIdx.x; idx < total; idx += gridDim.x * 512) {
        const int row = idx >> 5, i = idx & 31; const bool meta = row >= MROWS;
        const int pos = meta ? row - MROWS : 16 + (row & (SEQ - 1));
        const bf16_t* src = meta ? cm + (size_t)(row - MROWS) * CP : cb + (size_t)row * CP;
        bf16_t* dst = meta ? krm + (size_t)(48 + row - MROWS) * 64 : kr + (size_t)row * 64;
        float c, sn; att::rope_cs(pos, i, c, sn);
        const float x1 = __uint_as_float((unsigned)src[1280 + i] << 16), x2 = __uint_as_float((unsigned)src[1312 + i] << 16);
        const unsigned w = pkbf(x1 * c - x2 * sn, x1 * sn + x2 * c);
        dst[i] = (bf16_t)(w & 0xffffu); dst[32 + i] = (bf16_t)(w >> 16);
    }
}
typedef short bf16x8_t __attribute__((ext_vector_type(8)));
template <int NACC, class F>
__device__ __forceinline__ void skinny_block(LAS unsigned char* lds, const bf16_t* A, int lda, const bf16_t* B0, const bf16_t* B1, int ldb, int K, F&& f) {
    const int lane = threadIdx.x & 63, wid = threadIdx.x >> 6, fr = lane & 15, fq = lane >> 4, kw = K >> 3;
    const bf16_t* ap = A + (size_t)fr * lda + wid * kw + 8 * fq;
    const bf16_t* bp0 = B0 + (size_t)fr * ldb + wid * kw + 8 * fq; const bf16_t* bp1 = B1 + (size_t)fr * ldb + wid * kw + 8 * fq;
    f32x4 acc0[4], acc1[4];
#pragma unroll
    for (int c = 0; c < 4; ++c) { acc0[c] = (f32x4){0.f, 0.f, 0.f, 0.f}; acc1[c] = acc0[c]; }
    for (int k = 0; k < kw; k += 32) {
        const bf16x8_t a = *(const bf16x8_t*)(ap + k);
#pragma unroll
        for (int c = 0; c < 4; ++c) {
            const bf16x8_t b0 = *(const bf16x8_t*)(bp0 + (size_t)(16 * c) * ldb + k);
            acc0[c] = __builtin_amdgcn_mfma_f32_16x16x32_bf16(a, b0, acc0[c], 0, 0, 0);
            if (NACC == 2) { const bf16x8_t b1 = *(const bf16x8_t*)(bp1 + (size_t)(16 * c) * ldb + k); acc1[c] = __builtin_amdgcn_mfma_f32_16x16x32_bf16(a, b1, acc1[c], 0, 0, 0); }
        }
    }
    LAS f32x4* red = (LAS f32x4*)lds;
#pragma unroll
    for (int c = 0; c < 4; ++c) { red[(c * 8 + wid) * 64 + lane] = acc0[c]; if (NACC == 2) red[((4 + c) * 8 + wid) * 64 + lane] = acc1[c]; }
    __syncthreads();
    if (wid == 0) {
#pragma unroll
        for (int c = 0; c < 4; ++c) {
            f32x4 s0 = red[(c * 8) * 64 + lane];
#pragma unroll
            for (int w = 1; w < 8; ++w) s0 = s0 + red[(c * 8 + w) * 64 + lane];
            acc0[c] = s0;
            if (NACC == 2) { f32x4 s1 = red[((4 + c) * 8) * 64 + lane];
#pragma unroll
                for (int w = 1; w < 8; ++w) s1 = s1 + red[((4 + c) * 8 + w) * 64 + lane];
                acc1[c] = s1; }
        }
        f(acc0, acc1, fr, 4 * fq);
    }
    __syncthreads();
}
#define SKINNY_FOR(blk, nblk) for (int blk = (int)gridDim.x - 1 - (int)blockIdx.x; blk < (nblk); blk += (int)gridDim.x)

template <class Epi> __device__ __forceinline__ void run_gemm(LAS unsigned char* lds, const bf16_t* A, int lda, const bf16_t* Bt, int ldb, int N, int K, const Epi& E) {
    pg8::Gemm g{A, Bt, MROWS, N, K, lda, ldb}; pg8::StaticOrder S; S.init(MROWS, N, gridDim.x, blockIdx.x);
    pg8::gemm_phase<Epi, pg8::StaticOrder, true, true>(lds, g, S, E);
}

#ifndef USE_GRID_SYNC
#define USE_GRID_SYNC 1
#endif
constexpr int NPHASE = 13;
constexpr int LDS_BYTES = 132096;

__global__ void __launch_bounds__(512, 2) fwd_kernel(Params p) {
    extern __shared__ __attribute__((aligned(16))) unsigned char lds_raw[];
    LAS unsigned char* lds = (LAS unsigned char*)lds_raw;
    unsigned char* ws = p.ws;
#define HN ((bf16_t*)(ws + OFF_HN))
#define FB ((bf16_t*)(ws + OFF_F))
#define ACT ((bf16_t*)(ws + OFF_BIG))
#define GATES ((bf16_t*)(ws + OFF_F))
#define DAQKV ((bf16_t*)(ws + OFF_BIG))
#define CBUF ((bf16_t*)(ws + OFF_CBUF))
#define QMLA ((bf16_t*)(ws + OFF_QMLA))
#define KVMLA ((bf16_t*)(ws + OFF_FFN))
#define KR ((bf16_t*)(ws + OFF_KR))
#define YDA HN
#define YMLA (HN + (size_t)MROWS * 1024)
#define TMP ((bf16_t*)(ws + OFF_BIG))
#define MERGED ((bf16_t*)(ws + OFF_FFN))
#define RSQ ((float*)(ws + OFF_RSQ))
#define RSKV ((float*)(ws + OFF_RSKV))
#define CTL ((int*)(ws + OFF_CTL))
    const int gtid = blockIdx.x * 512 + threadIdx.x, gthreads = gridDim.x * 512;
#if USE_GRID_SYNC
    cg::grid_group grid = cg::this_grid();
    { volatile LAS unsigned* st = (volatile LAS unsigned*)(lds + 131072); if (threadIdx.x < 2) st[threadIdx.x] = 0u; __syncthreads(); }
    XcdBarrier bar = xcd_barrier_post((unsigned*)(ws + OFF_CTL + 16384), (volatile LAS unsigned*)(lds + 131072));
    if (p.ph_lo < 0) grid.sync();
#define SEAM(ph) do { if ((ph) + 1 < p.ph_hi) xcd_barrier(bar); } while (0)
#else
#define SEAM(ph) do { } while (0)
#endif
#ifndef PHMASK
#define PHMASK 0x1fff
#endif
#define IN(ph) (((PHMASK >> (ph)) & 1) && p.ph_lo <= (ph) && (ph) < p.ph_hi)
#define M_HN ((bf16_t*)(ws + OFF_M_HN))
#define M_ACT ((bf16_t*)(ws + OFF_M_ACT))
#define M_F ((float*)(ws + OFF_M_F))
#define M_C ((bf16_t*)(ws + OFF_M_C))
#define M_HN2 ((bf16_t*)(ws + OFF_M_HN2))
#define M_DAQKV ((bf16_t*)(ws + OFF_M_DAQKV))
#define M_KVMLA ((bf16_t*)(ws + OFF_M_KVMLA))
#define M_KR ((bf16_t*)(ws + OFF_M_KR))
    if (IN(0)) {
        for (int i = gtid; i < 2 * MROWS; i += gthreads) { if (i < MROWS) RSQ[i] = 0.f; else RSKV[i - MROWS] = 0.f; }
        if (gtid < 64) CTL[gtid] = 0;
        { u32x4* z = (u32x4*)((bf16_t*)(ws + OFF_WIN) + (size_t)8512 * 2048); for (int i = gtid; i < 192 * 2048 / 8; i += gthreads) z[i] = (u32x4){0u, 0u, 0u, 0u}; }
        for (int i = gtid; i < (48 * 3072 + 48 * 2048 + 48 * 64) / 8; i += gthreads) {
            u32x4* z = i < 48 * 3072 / 8 ? (u32x4*)(ws + OFF_M_DAQKV) + i : (i < (48 * 3072 + 48 * 2048) / 8 ? (u32x4*)(ws + OFF_M_KVMLA) + (i - 48 * 3072 / 8) : (u32x4*)(ws + OFF_M_KR) + (i - (48 * 3072 + 48 * 2048) / 8));
            *z = (u32x4){0u, 0u, 0u, 0u}; }
        norm_rows(p, true, nullptr, 0.f, nullptr, p.in[I_F1PRE]);
        norm_meta(p, nullptr, nullptr, p.in[I_F1PRE], M_HN);
        cvt_jobs<0, 9>(p, (LAS float*)lds);
        SEAM(0);
    }
    if (IN(1)) {
        { pg8::EpiAct E{ACT}; run_gemm(lds, HN, D, (const bf16_t*)(ws + OFF_FFN), D, 2 * FF, D, E); }
        __syncthreads();
        SKINNY_FOR(blk, FF / 64) {
            const int n0 = 64 * blk; const bf16_t* B0 = (const bf16_t*)(ws + OFF_FFN) + (size_t)(256 * (n0 >> 7) + (n0 & 127)) * D;
            skinny_block<2>(lds, M_HN, D, B0, B0 + (size_t)128 * D, D, D, [&](const f32x4 (&g)[4], const f32x4 (&u)[4], int n, int m0) {
#pragma unroll
                for (int c = 0; c < 4; ++c)
#pragma unroll
                    for (int r = 0; r < 4; ++r) M_ACT[(size_t)(m0 + r) * FF + n0 + 16 * c + n] = (bf16_t)(pkbf(g[c][r] * pg8::sigmoidf_(g[c][r]) * u[c][r], 0.f) & 0xffffu); });
        }
        SEAM(1);
    }
    if (IN(2)) {
        { pg8::EpiBf16 E{FB, D}; run_gemm(lds, ACT, FF, (const bf16_t*)(ws + OFF_WD), FF, D, FF, E); }
        __syncthreads();
        SKINNY_FOR(blk, D / 64) {
            const int n0 = 64 * blk; const bf16_t* B0 = (const bf16_t*)(ws + OFF_WD) + (size_t)n0 * FF;
            skinny_block<1>(lds, M_ACT, FF, B0, B0, FF, FF, [&](const f32x4 (&v)[4], const f32x4 (&)[4], int n, int m0) {
#pragma unroll
                for (int c = 0; c < 4; ++c)
#pragma unroll
                    for (int r = 0; r < 4; ++r) M_F[(size_t)(m0 + r) * D + n0 + 16 * c + n] = v[c][r]; });
        }
        SEAM(2);
    }
    if (IN(3)) { norm_rows(p, true, FB, 0.5f, p.in[I_F1POST], p.in[I_MIXPRE]); norm_meta(p, M_F, p.in[I_F1POST], p.in[I_MIXPRE], M_HN2); SEAM(3); }
    if (IN(4)) {
        { pg8::EpiInProj E{GATES, DAQKV, CBUF, p.in[I_BGATE], RSQ, RSKV}; run_gemm(lds, HN, D, (const bf16_t*)(ws + OFF_WIN), D, NIN, D, E); }
        __syncthreads();
        SKINNY_FOR(blk, 41) {
            const int nrow = blk < 32 ? 5120 + 64 * blk : (blk < 40 ? 7936 + 64 * (blk - 32) : 8448);
            const bf16_t* B0 = (const bf16_t*)(ws + OFF_WIN) + (size_t)nrow * D;
            bf16_t* dst = blk < 32 ? M_DAQKV + (size_t)48 * 3072 + (nrow - 4096) : M_C + (blk < 40 ? 768 + (nrow - 7936) : 1280);
            const int ldd = blk < 32 ? 3072 : CP;
            skinny_block<1>(lds, M_HN2, D, B0, B0, D, D, [&](const f32x4 (&v)[4], const f32x4 (&)[4], int n, int m0) {
#pragma unroll
                for (int c = 0; c < 4; ++c)
#pragma unroll
                    for (int r = 0; r < 4; ++r) dst[(size_t)(m0 + r) * ldd + 16 * c + n] = (bf16_t)(pkbf(v[c][r], 0.f) & 0xffffu); });
        }
        SEAM(4);
    }
    if (IN(5)) {
        { pg8::EpiRowScale E{QMLA, 1536, RSQ, 1.f / 768.f}; run_gemm(lds, CBUF, CP, (const bf16_t*)(ws + OFF_WUQ), 768, 1536, 768, E); }
        __syncthreads();
        { pg8::EpiRowScale E{KVMLA, 2048, RSKV, 1.f / 512.f}; run_gemm(lds, CBUF + 768, CP, (const bf16_t*)(ws + OFF_WUKV), 512, 2048, 512, E); }
        __syncthreads();
        {
            LAS float* rsl = (LAS float*)(lds + 98304); const int lane = threadIdx.x & 63, wid = threadIdx.x >> 6;
            for (int rr = 2 * wid; rr < 2 * wid + 2; ++rr) { const u32x4 w = *(const u32x4*)(M_C + (size_t)rr * CP + 768 + 8 * lane); float ss = 0.f;
#define SQ2(x) { const float lo_ = __uint_as_float((x) << 16), hi_ = __uint_as_float((x) & 0xffff0000u); ss += lo_ * lo_ + hi_ * hi_; }
                SQ2(w.x) SQ2(w.y) SQ2(w.z) SQ2(w.w)
#undef SQ2
                ss = wave_sum(ss); if (lane == 0) rsl[rr] = ss; }
            __syncthreads();
            SKINNY_FOR(blk, D / 64) {
                const int n0 = 64 * blk; const bf16_t* B0 = (const bf16_t*)(ws + OFF_WUKV) + (size_t)n0 * 512;
                skinny_block<1>(lds, M_C + 768, CP, B0, B0, 512, 512, [&](const f32x4 (&v)[4], const f32x4 (&)[4], int n, int m0) {
#pragma unroll
                    for (int r = 0; r < 4; ++r) { const float sc = __builtin_amdgcn_rsqf(rsl[m0 + r] * (1.f / 512.f) + RMS_EPS);
#pragma unroll
                        for (int c = 0; c < 4; ++c) M_KVMLA[(size_t)(48 + m0 + r) * 2048 + n0 + 16 * c + n] = (bf16_t)(pkbf(v[c][r] * sc, 0.f) & 0xffffu); } });
            }
        }
        rope_k_rows(p);
        SEAM(5);
    }
    if (IN(6)) {
        att::AttnArgs A{DAQKV, QMLA, KVMLA, KR, M_DAQKV, M_KVMLA, M_KR, YDA, YMLA, p.in[I_TABLE], p.in[I_SUBG], p.in[I_LQ1], p.in[I_LK1], p.in[I_LQ2], p.in[I_LK2], CTL + 0};
        if (threadIdx.x >= 256) __builtin_amdgcn_s_setprio(1);
        att::attn_phase(lds, A);
        __builtin_amdgcn_s_setprio(0);
        SEAM(6);
    }
    if (IN(7)) {
        { pg8::EpiGate<0> E{GATES, TMP, MERGED, p.in[I_BGATE]}; run_gemm(lds, YDA, 1024, (const bf16_t*)(ws + OFF_WBDA), 1024, D, 1024, E); }
        __syncthreads();
        { pg8::EpiGate<1> E{GATES, TMP, MERGED, p.in[I_BGATE]}; run_gemm(lds, YMLA, 1024, (const bf16_t*)(ws + OFF_WBMLA), 1024, D, 1024, E); }
        SEAM(7);
    }
    if (IN(8)) { pg8::EpiBf16 E{FB, D}; run_gemm(lds, MERGED, D, (const bf16_t*)(ws + OFF_WOUT), D, D, D, E); SEAM(8); }
    if (IN(9)) { norm_rows(p, false, FB, 1.0f, p.in[I_MIXPOST], p.in[I_F2PRE]); cvt_jobs<9, 12>(p, (LAS float*)lds); SEAM(9); }
    if (IN(10)) { pg8::EpiAct E{ACT}; run_gemm(lds, HN, D, (const bf16_t*)(ws + OFF_FFN), D, 2 * FF, D, E); SEAM(10); }
    if (IN(11)) { pg8::EpiBf16 E{FB, D}; run_gemm(lds, ACT, FF, (const bf16_t*)(ws + OFF_WD), FF, D, FF, E); SEAM(11); }
    if (IN(12)) { norm_rows(p, false, FB, 0.5f, p.in[I_F2POST], nullptr); }
}


#ifdef DBG_STOP
__global__ void dbg_dump(const unsigned short* src, float* out, size_t n) {
    for (size_t i = (size_t)blockIdx.x * 256 + threadIdx.x; i < n; i += (size_t)gridDim.x * 256) out[i] = __uint_as_float((unsigned)src[i] << 16);
}
#endif
extern "C" void kernel_launch(void* const* d_in, const int* in_sizes, int n_in, void* d_out, int out_size, void* d_ws, size_t ws_size, hipStream_t stream) {
    static int grid = 0;
    if (grid == 0) {
        if (n_in != 29 || ws_size < WS_NEED || out_size != NBATCH * SEQ * D) { fprintf(stderr, "kernel_launch: unexpected problem (n_in %d, ws %zu need %zu, out %d)\n", n_in, ws_size, (size_t)WS_NEED, out_size); grid = -1; return; }
        int dev = 0, cus = 0, per_cu = 0;
        hipGetDevice(&dev); hipDeviceGetAttribute(&cus, hipDeviceAttributeMultiprocessorCount, dev);
        if (hipFuncSetAttribute((const void*)fwd_kernel, hipFuncAttributeMaxDynamicSharedMemorySize, LDS_BYTES) != hipSuccess) { fprintf(stderr, "hipFuncSetAttribute failed\n"); grid = -1; return; }
        if (hipOccupancyMaxActiveBlocksPerMultiprocessor(&per_cu, (const void*)fwd_kernel, 512, LDS_BYTES) != hipSuccess || per_cu < 1) { fprintf(stderr, "occupancy query: %d\n", per_cu); per_cu = 1; }
        (void)hipGetLastError();
        grid = cus * 1;
    }
    if (grid < 0) return;
    Params p{};
    for (int i = 0; i < 29; ++i) p.in[i] = (const float*)d_in[i];
    p.out = (float*)d_out; p.ws = (unsigned char*)d_ws;
#if USE_GRID_SYNC
#ifndef CUTS
#define CUTS {0, NPHASE}
#endif
    const int cuts[] = CUTS;
    for (int li = 0; li + 1 < (int)(sizeof(cuts) / sizeof(int)); ++li) {
        p.ph_lo = cuts[li]; p.ph_hi = cuts[li + 1];
        if (hipMemsetAsync((char*)d_ws + OFF_CTL + 16384, 0, 16384, stream) != hipSuccess) { fprintf(stderr, "memset failed\n"); return; }
        void* args[] = {&p};
        hipError_t e = hipLaunchCooperativeKernel((const void*)fwd_kernel, dim3(grid), dim3(512), args, LDS_BYTES, stream);
        if (e != hipSuccess) fprintf(stderr, "cooperative launch failed: %s (grid %d)\n", hipGetErrorString(e), grid);
    }
#else
#ifdef DBG_STOP
    for (int ph = 0; ph <= DBG_STOP; ++ph) { p.ph_lo = ph; p.ph_hi = ph + 1; hipLaunchKernelGGL(fwd_kernel, dim3(grid), dim3(512), LDS_BYTES, stream, p); }
#ifdef DBG_DUMP_OFF
    hipLaunchKernelGGL(dbg_dump, dim3(2048), dim3(256), 0, stream, (const unsigned short*)((unsigned char*)d_ws + (size_t)(DBG_DUMP_OFF)), (float*)d_out, (size_t)NBATCH * SEQ * D);
#endif
#else
    for (int ph = 0; ph < NPHASE; ++ph) { p.ph_lo = ph; p.ph_hi = ph + 1; hipLaunchKernelGGL(fwd_kernel, dim3(grid), dim3(512), LDS_BYTES, stream, p); }
#endif
#endif
}
```

```cpp
#include <hip/hip_runtime.h>
#include <hip/hip_cooperative_groups.h>
#include <cstdio>
#include <cstdint>
namespace cg = cooperative_groups;

constexpr int D = 2048, NBATCH = 2, SEQ = 8192, MROWS = NBATCH * SEQ, FF = 5632;
constexpr int NIN = 8704;
constexpr float RMS_EPS = 1e-6f;
constexpr float LOG2E = 1.4426950408889634f;

constexpr size_t OFF_CTL = 0, OFF_RSQ = 65536, OFF_RSKV = 131072, OFF_KR = 262144;
constexpr size_t OFF_M_HN = 2621440, OFF_M_ACT = 2686976, OFF_M_F = 2867200, OFF_M_C = 2998272, OFF_M_HN2 = 3041536;
constexpr size_t OFF_M_DAQKV = 3145728, OFF_M_KVMLA = 3538944, OFF_M_KR = 3801088, OFF_M_END = 3809280;
constexpr size_t OFF_WIN = 8388608, OFF_WUQ = 44040192, OFF_WUKV = 46399488, OFF_WBDA = 48496640, OFF_WBMLA = 52690944, OFF_WOUT = 56885248;
constexpr size_t OFF_FFN = 65273856, OFF_WD = 111411200;
constexpr size_t OFF_HN = 134479872, OFF_F = 201588736, OFF_BIG = 335806464, WS_NEED = 530841600;
constexpr size_t OFF_CBUF = OFF_BIG + 100663296, OFF_QMLA = OFF_CBUF + 44040192;
constexpr int CP = 1344;

namespace pg8 {
#define PG8_LAS __attribute__((address_space(3)))
typedef unsigned short bf16_t;
typedef short bf16x8 __attribute__((ext_vector_type(8)));
typedef float f32x4 __attribute__((ext_vector_type(4)));
typedef unsigned u32x4 __attribute__((ext_vector_type(4)));
constexpr int BM = 256, BK = 64, HALF = 128, HTB = HALF * BK * 2  , STAGE_BYTES = 8 * HTB, NXCD = 8, WGM = 8;

__host__ __device__ __forceinline__ int lds_byte(int r, int c) { const int st = (r >> 4) * 2 + (c >> 5), rr = r & 15, cc = c & 31, ob = rr * 64 + cc * 2; return st * 1024 + (ob ^ (((ob >> 9) & 1) << 5)); }
__host__ __device__ __forceinline__ void stage_rc(int b, int& R, int& C) { const int st = b / 1024, sb = b % 1024, swz = sb ^ (((sb >> 9) & 1) << 5); R = (st >> 1) * 16 + swz / 64; C = (st & 1) * 32 + (swz % 64) / 2; }
__host__ __device__ __forceinline__ int perm32(int rho) { const int n = rho >> 4, i = rho & 15; return 8 * (i >> 2) + 4 * n + (i & 3); }

struct Unit { int pm, pn; };
struct Gemm { const bf16_t* A; const bf16_t* Bt; int M, N, K, lda, ldb; };

struct StaticOrder {
    int nM, nN, nwg, G, c;
    __host__ __device__ void init(int M, int N, int G_, int c_) { nM = M / BM; nN = N / BM; nwg = nM * nN; G = G_; c = c_; }
    __host__ __device__ bool next(int i, Unit& u) const {
        const long L = (long)i * G + c; if (L >= nwg) return false;
        int wgid = (int)L; { const int q = nwg / NXCD, r = nwg % NXCD, xcd = wgid % NXCD, off = wgid / NXCD; wgid = (xcd < r ? xcd * (q + 1) : r * (q + 1) + (xcd - r) * q) + off; }
        const int nig = WGM * nN, gid = wgid / nig, fm = gid * WGM, gsz = (nM - fm) < WGM ? (nM - fm) : WGM;
        u.pm = fm + ((wgid % nig) % gsz); u.pn = (wgid % nig) / gsz; return true;
    }
    __device__ __forceinline__ void a_ready(const Unit&) const {}
    __device__ __forceinline__ void done(const Unit&) const {}
};

__device__ __forceinline__ unsigned cvt_pk_bf16(float lo, float hi) { unsigned r; asm volatile("v_cvt_pk_bf16_f32 %0, %1, %2" : "=v"(r) : "v"(lo), "v"(hi)); return r; }
__device__ __forceinline__ float bf_lo(unsigned w) { return __uint_as_float(w << 16); }
__device__ __forceinline__ float bf_hi(unsigned w) { return __uint_as_float(w & 0xffff0000u); }
__device__ __forceinline__ float sigmoidf_(float x) { return __builtin_amdgcn_rcpf(1.f + __expf(-x)); }
typedef unsigned u32x2 __attribute__((ext_vector_type(2)));

struct EpiAct {
    static constexpr bool PERM = true, AFTER_DRAIN = false;
    bf16_t* O;
    __device__ __forceinline__ void operator()(const f32x4 (&acc)[2][2][4][2], const Unit& u, int wr, int wc, int fr, int fq) const {
        const int row0 = u.pm * BM + wr * 64 + fr, col0 = u.pn * 128 + wc * 32 + 8 * fq;
#pragma unroll
        for (int ai = 0; ai < 2; ++ai)
#pragma unroll
            for (int m = 0; m < 4; ++m) {
                float v[8];
#pragma unroll
                for (int n = 0; n < 2; ++n)
#pragma unroll
                    for (int j = 0; j < 4; ++j) { const float g = acc[ai][0][m][n][j], up = acc[ai][1][m][n][j]; v[n * 4 + j] = g * sigmoidf_(g) * up; }
                u32x4 w; w.x = cvt_pk_bf16(v[0], v[1]); w.y = cvt_pk_bf16(v[2], v[3]); w.z = cvt_pk_bf16(v[4], v[5]); w.w = cvt_pk_bf16(v[6], v[7]);
                *(u32x4*)(O + (size_t)(row0 + ai * HALF + m * 16) * FF + col0) = w;
            }
    }
};
struct EpiBf16 {
    static constexpr bool PERM = true, AFTER_DRAIN = false;
    bf16_t* O; int ldc;
    __device__ __forceinline__ void operator()(const f32x4 (&acc)[2][2][4][2], const Unit& u, int wr, int wc, int fr, int fq) const {
        const int row0 = u.pm * BM + wr * 64 + fr, col0 = u.pn * BM + wc * 32 + 8 * fq;
#pragma unroll
        for (int ai = 0; ai < 2; ++ai)
#pragma unroll
            for (int m = 0; m < 4; ++m) { bf16_t* rowp = O + (size_t)(row0 + ai * HALF + m * 16) * ldc + col0;
#pragma unroll
                for (int bj = 0; bj < 2; ++bj) { const f32x4 v0 = acc[ai][bj][m][0], v1 = acc[ai][bj][m][1];
                    u32x4 w; w.x = cvt_pk_bf16(v0[0], v0[1]); w.y = cvt_pk_bf16(v0[2], v0[3]); w.z = cvt_pk_bf16(v1[0], v1[1]); w.w = cvt_pk_bf16(v1[2], v1[3]);
                    *(u32x4*)(rowp + bj * HALF) = w; } }
    }
};
struct EpiF32 {
    static constexpr bool PERM = false, AFTER_DRAIN = false;
    float* O; int ldc;
    __device__ __forceinline__ void operator()(const f32x4 (&acc)[2][2][4][2], const Unit& u, int wr, int wc, int fr, int fq) const {
        const int row0 = u.pm * BM + wr * 64 + fr, col0 = u.pn * BM + wc * 32 + 4 * fq;
#pragma unroll
        for (int ai = 0; ai < 2; ++ai)
#pragma unroll
            for (int m = 0; m < 4; ++m) { float* rowp = O + (size_t)(row0 + ai * HALF + m * 16) * ldc + col0;
#pragma unroll
                for (int bj = 0; bj < 2; ++bj)
#pragma unroll
                    for (int n = 0; n < 2; ++n) *(f32x4*)(rowp + bj * HALF + n * 16) = acc[ai][bj][m][n]; }
    }
};
struct EpiInProj {
    static constexpr bool PERM = true, AFTER_DRAIN = false;
    bf16_t* gates; bf16_t* daqkv; bf16_t* cbuf; const float* bgate; float* rsq; float* rskv;
    __device__ __forceinline__ void operator()(const f32x4 (&acc)[2][2][4][2], const Unit& u, int wr, int wc, int fr, int fq) const {
        const int row0 = u.pm * BM + wr * 64 + fr, lc0 = wc * 32 + 8 * fq;
        const int pn = u.pn;
        {
            bf16_t* base; int ldc, cb; float* rs = nullptr;
            if (pn < 16) { base = gates; ldc = 4096; cb = pn * BM; }
            else if (pn < 28) { base = daqkv; ldc = 3072; cb = (pn - 16) * BM; }
            else { base = cbuf; ldc = CP; cb = (pn - 28) * BM; if (pn < 31) rs = rsq; else if (pn < 33) rs = rskv; }
            const bool last = (pn == 33);
#pragma unroll
            for (int ai = 0; ai < 2; ++ai)
#pragma unroll
                for (int m = 0; m < 4; ++m) { const int row = row0 + ai * HALF + m * 16; bf16_t* rowp = base + (size_t)row * ldc + cb + lc0; float ss = 0.f;
#pragma unroll
                    for (int bj = 0; bj < 2; ++bj) { const f32x4 v0 = acc[ai][bj][m][0], v1 = acc[ai][bj][m][1];
                        ss += (v0[0] * v0[0] + v0[1] * v0[1]) + (v0[2] * v0[2] + v0[3] * v0[3]) + (v1[0] * v1[0] + v1[1] * v1[1]) + (v1[2] * v1[2] + v1[3] * v1[3]);
                        u32x4 w; w.x = cvt_pk_bf16(v0[0], v0[1]); w.y = cvt_pk_bf16(v0[2], v0[3]); w.z = cvt_pk_bf16(v1[0], v1[1]); w.w = cvt_pk_bf16(v1[2], v1[3]);
                        if (!last || (bj == 0 && lc0 < 64)) *(u32x4*)(rowp + bj * HALF) = w; }
                    if (rs) { ss += __shfl_xor(ss, 16); ss += __shfl_xor(ss, 32); if (fq == 0) atomicAdd(rs + row, ss); } }
        }
    }
};
struct EpiRowScale {
    static constexpr bool PERM = true, AFTER_DRAIN = false;
    bf16_t* O; int ldc; const float* rs; float invk;
    __device__ __forceinline__ void operator()(const f32x4 (&acc)[2][2][4][2], const Unit& u, int wr, int wc, int fr, int fq) const {
        const int row0 = u.pm * BM + wr * 64 + fr, col0 = u.pn * BM + wc * 32 + 8 * fq;
        float sq[8];
#pragma unroll
        for (int i = 0; i < 8; ++i) sq[i] = __hip_atomic_load(rs + row0 + (i >> 2) * HALF + (i & 3) * 16, __ATOMIC_RELAXED, __HIP_MEMORY_SCOPE_AGENT);
#pragma unroll
        for (int ai = 0; ai < 2; ++ai)
#pragma unroll
            for (int m = 0; m < 4; ++m) { const int row = row0 + ai * HALF + m * 16; const float sc = __builtin_amdgcn_rsqf(sq[ai * 4 + m] * invk + RMS_EPS); bf16_t* rowp = O + (size_t)row * ldc + col0;
#pragma unroll
                for (int bj = 0; bj < 2; ++bj) { const f32x4 v0 = acc[ai][bj][m][0] * sc, v1 = acc[ai][bj][m][1] * sc;
                    u32x4 w; w.x = cvt_pk_bf16(v0[0], v0[1]); w.y = cvt_pk_bf16(v0[2], v0[3]); w.z = cvt_pk_bf16(v1[0], v1[1]); w.w = cvt_pk_bf16(v1[2], v1[3]);
                    *(u32x4*)(rowp + bj * HALF) = w; } }
    }
};
template <int PASS> struct EpiGate {
    static constexpr int MID_K_UNUSED = 0;
    static constexpr bool PERM = true, AFTER_DRAIN = false;
    const bf16_t* gates; bf16_t* tmp; bf16_t* merged; const float* bgate;
    __device__ __forceinline__ void operator()(const f32x4 (&acc)[2][2][4][2], const Unit& u, int wr, int wc, int fr, int fq) const {
        const int row0 = u.pm * BM + wr * 64 + fr, col0 = u.pn * BM + wc * 32 + 8 * fq;
        f32x4 bb[2][2];
#pragma unroll
        for (int bj = 0; bj < 2; ++bj)
#pragma unroll
            for (int n = 0; n < 2; ++n) bb[bj][n] = *(const f32x4*)(bgate + PASS * 2048 + col0 + bj * HALF + 4 * n);
#pragma unroll
        for (int ai = 0; ai < 2; ++ai)
#pragma unroll
            for (int m = 0; m < 4; ++m) { const size_t row = (size_t)(row0 + ai * HALF + m * 16);
#pragma unroll
                for (int bj = 0; bj < 2; ++bj) { const int col = col0 + bj * HALF;
                    const u32x4 gw = __builtin_nontemporal_load((const u32x4*)(gates + row * 4096 + PASS * 2048 + col));
                    f32x4 v0 = acc[ai][bj][m][0], v1 = acc[ai][bj][m][1];
                    v0[0] *= sigmoidf_(bf_lo(gw.x) + bb[bj][0][0]); v0[1] *= sigmoidf_(bf_hi(gw.x) + bb[bj][0][1]); v0[2] *= sigmoidf_(bf_lo(gw.y) + bb[bj][0][2]); v0[3] *= sigmoidf_(bf_hi(gw.y) + bb[bj][0][3]);
                    v1[0] *= sigmoidf_(bf_lo(gw.z) + bb[bj][1][0]); v1[1] *= sigmoidf_(bf_hi(gw.z) + bb[bj][1][1]); v1[2] *= sigmoidf_(bf_lo(gw.w) + bb[bj][1][2]); v1[3] *= sigmoidf_(bf_hi(gw.w) + bb[bj][1][3]);
                    if (PASS == 1) { const u32x4 tw = *(const u32x4*)(tmp + row * D + col);
                        v0[0] += bf_lo(tw.x); v0[1] += bf_hi(tw.x); v0[2] += bf_lo(tw.y); v0[3] += bf_hi(tw.y); v1[0] += bf_lo(tw.z); v1[1] += bf_hi(tw.z); v1[2] += bf_lo(tw.w); v1[3] += bf_hi(tw.w); }
                    u32x4 w; w.x = cvt_pk_bf16(v0[0], v0[1]); w.y = cvt_pk_bf16(v0[2], v0[3]); w.z = cvt_pk_bf16(v1[0], v1[1]); w.w = cvt_pk_bf16(v1[2], v1[3]);
                    *(u32x4*)((PASS == 0 ? tmp : merged) + row * D + col) = w; } }
    }
};

template <class Epi, class Sched, bool ALIGN_EPI = false, bool SP2 = false>
__device__ __forceinline__ void gemm_phase(PG8_LAS unsigned char* lds, const Gemm g, const Sched& S, const Epi& E) {
    const int tid = threadIdx.x, wid = __builtin_amdgcn_readfirstlane(tid >> 6), lane = tid & 63, wr = wid >> 2, wc = wid & 3, fr = lane & 15, fq = lane >> 4;
    const int K = g.K, nt = K / BK;
    unsigned voffA[2], voffB[2];
#pragma unroll
    for (int i = 0; i < 2; ++i) { int R, C; stage_rc(tid * 16 + i * 8192, R, C); const int Rb = Epi::PERM ? ((R & ~31) + perm32(R & 31)) : R;
        voffA[i] = (unsigned)(R * g.lda + C) * 2u; voffB[i] = (unsigned)(Rb * g.ldb + C) * 2u; }
    const size_t kstep = (size_t)(BK * 2);
    const size_t hstepA = (size_t)HALF * g.lda * 2, hstepB = (size_t)HALF * g.ldb * 2;
    const size_t tstepA = 2 * hstepA, tstepB = 2 * hstepB;
    const unsigned ldsw = (unsigned)wid * 1024u;
    const int aoff = lds_byte(wr * 64 + fr, fq * 8), boff = lds_byte(wc * 32 + fr, fq * 8);
#define PG8_SA(b, h) (((b) * 2 + (h)) * HTB)
#define PG8_SB(b, h) ((4 + (b) * 2 + (h)) * HTB)
#define PG8_STAGE(bufoff, gbase, voff) do { _Pragma("unroll") for (int _i = 0; _i < 2; ++_i) \
        __builtin_amdgcn_global_load_lds((const unsigned*)((const char*)(gbase) + (voff)[_i]), (PG8_LAS unsigned*)(lds + (bufoff) + ldsw + _i * 8192), 16, 0, 0); } while (0)
#define PG8_LDA(dst, b, h) do { _Pragma("unroll") for (int m = 0; m < 4; ++m) _Pragma("unroll") for (int k = 0; k < 2; ++k) dst[m][k] = *(const PG8_LAS bf16x8*)(lds + PG8_SA(b, h) + aoff + m * 2048 + k * 1024); } while (0)
#define PG8_LDB(dst, b, h) do { _Pragma("unroll") for (int n = 0; n < 2; ++n) _Pragma("unroll") for (int k = 0; k < 2; ++k) dst[n][k] = *(const PG8_LAS bf16x8*)(lds + PG8_SB(b, h) + boff + n * 2048 + k * 1024); } while (0)
#define PG8_MMA(ai, bj, At, Bt) do { __builtin_amdgcn_s_setprio(1); _Pragma("unroll") for (int m = 0; m < 4; ++m) _Pragma("unroll") for (int n = 0; n < 2; ++n) _Pragma("unroll") for (int k = 0; k < 2; ++k) \
        acc[ai][bj][m][n] = __builtin_amdgcn_mfma_f32_16x16x32_bf16(Bt[n][k], At[m][k], acc[ai][bj][m][n], 0, 0, 0); __builtin_amdgcn_s_setprio(0); } while (0)
#define PG8_WAIT_V(n) asm volatile("s_waitcnt vmcnt(" #n ")" ::: "memory")
#define PG8_WAIT_L(n) asm volatile("s_waitcnt lgkmcnt(" #n ")" ::: "memory")
#define PG8_BAR __builtin_amdgcn_s_barrier()
#define PG8_SCHED __builtin_amdgcn_sched_barrier(0)
    Unit cur, nxt; int ui = 0;
    if (!S.next(0, cur)) return;
    f32x4 acc[2][2][4][2];
#pragma unroll
    for (int a = 0; a < 2; ++a)
#pragma unroll
        for (int b = 0; b < 2; ++b)
#pragma unroll
            for (int m = 0; m < 4; ++m)
#pragma unroll
                for (int n = 0; n < 2; ++n) acc[a][b][m][n] = (f32x4){0.f, 0.f, 0.f, 0.f};
    bf16x8 At[4][2], B0[2][2], B1[2][2];
    const char* cA = (const char*)g.A + (size_t)cur.pm * tstepA; const char* cB = (const char*)g.Bt + (size_t)cur.pn * tstepB;
    S.a_ready(cur);
    if constexpr (SP2) {
        PG8_STAGE(PG8_SB(0, 0), cB, voffB); PG8_STAGE(PG8_SB(0, 1), cB + hstepB, voffB); PG8_STAGE(PG8_SA(0, 0), cA, voffA); PG8_STAGE(PG8_SA(0, 1), cA + hstepA, voffA);
        if (wr == 1) PG8_BAR;
        PG8_WAIT_V(2); PG8_BAR;
        PG8_STAGE(PG8_SB(1, 0), cB + kstep, voffB); PG8_STAGE(PG8_SA(1, 0), cA + kstep, voffA); PG8_STAGE(PG8_SB(1, 1), cB + hstepB + kstep, voffB);
        PG8_WAIT_V(6); PG8_BAR;
    } else {
        PG8_STAGE(PG8_SB(0, 0), cB, voffB); PG8_STAGE(PG8_SA(0, 0), cA, voffA); PG8_STAGE(PG8_SB(0, 1), cB + hstepB, voffB); PG8_STAGE(PG8_SA(0, 1), cA + hstepA, voffA);
        if (wr == 1) PG8_BAR;
        PG8_WAIT_V(4); PG8_BAR;
        PG8_STAGE(PG8_SB(1, 0), cB + kstep, voffB); PG8_STAGE(PG8_SA(1, 0), cA + kstep, voffA); PG8_STAGE(PG8_SB(1, 1), cB + hstepB + kstep, voffB);
        PG8_WAIT_V(6); PG8_BAR;
    }
    for (;;) {
        const bool has_next = S.next(ui + 1, nxt);
        const char* nA = has_next ? (const char*)g.A + (size_t)nxt.pm * tstepA : cA; const char* nB = has_next ? (const char*)g.Bt + (size_t)nxt.pn * tstepB : cB;
        for (int t = 0; t < nt; t += 2) {
            const bool last = (t == nt - 2);
            const char* a1 = cA + (size_t)(t + 1) * kstep;
            const char* a2 = last ? nA : cA + (size_t)(t + 2) * kstep; const char* b2 = last ? nB : cB + (size_t)(t + 2) * kstep;
            const char* a3 = a2 + kstep; const char* b3 = b2 + kstep;
            if (last && has_next) S.a_ready(nxt);
            if constexpr (SP2) {
            PG8_LDB(B0, 0, 0); PG8_LDB(B1, 0, 1); PG8_SCHED; PG8_LDA(At, 0, 0); PG8_STAGE(PG8_SA(1, 1), a1 + hstepA, voffA);
            PG8_WAIT_V(8); PG8_WAIT_L(0); PG8_BAR; PG8_MMA(0, 0, At, B0); PG8_MMA(0, 1, At, B1); PG8_BAR; PG8_SCHED;
            PG8_LDA(At, 0, 1); PG8_STAGE(PG8_SB(0, 0), b2, voffB); PG8_STAGE(PG8_SB(0, 1), b2 + hstepB, voffB); PG8_STAGE(PG8_SA(0, 0), a2, voffA);
            PG8_WAIT_V(8); PG8_WAIT_L(0); PG8_BAR; PG8_MMA(1, 0, At, B0); PG8_MMA(1, 1, At, B1); PG8_BAR; PG8_SCHED;
            PG8_LDB(B0, 1, 0); PG8_LDB(B1, 1, 1); PG8_SCHED; PG8_LDA(At, 1, 0); PG8_STAGE(PG8_SA(0, 1), a2 + hstepA, voffA);
            PG8_WAIT_V(8); PG8_WAIT_L(0); PG8_BAR; PG8_MMA(0, 0, At, B0); PG8_MMA(0, 1, At, B1); PG8_BAR; PG8_SCHED;
            PG8_LDA(At, 1, 1); PG8_STAGE(PG8_SB(1, 0), b3, voffB); PG8_STAGE(PG8_SB(1, 1), b3 + hstepB, voffB); PG8_STAGE(PG8_SA(1, 0), a3, voffA);
            PG8_WAIT_V(8); PG8_WAIT_L(0); PG8_BAR; PG8_MMA(1, 0, At, B0); PG8_MMA(1, 1, At, B1); PG8_BAR; PG8_SCHED;
            } else {
            PG8_LDB(B0, 0, 0); PG8_SCHED; PG8_LDA(At, 0, 0); PG8_STAGE(PG8_SA(1, 1), a1 + hstepA, voffA);
            PG8_WAIT_L(8); PG8_BAR; PG8_WAIT_L(0); PG8_MMA(0, 0, At, B0); PG8_BAR; PG8_SCHED;
            PG8_LDB(B1, 0, 1); PG8_STAGE(PG8_SB(0, 0), b2, voffB);
            PG8_BAR; PG8_WAIT_L(0); PG8_MMA(0, 1, At, B1); PG8_BAR;
            PG8_LDA(At, 0, 1); PG8_STAGE(PG8_SA(0, 0), a2, voffA);
            PG8_BAR; PG8_WAIT_L(0); PG8_MMA(1, 0, At, B0); PG8_BAR; PG8_SCHED;
            PG8_STAGE(PG8_SB(0, 1), b2 + hstepB, voffB);
            PG8_WAIT_V(6); PG8_BAR; PG8_MMA(1, 1, At, B1); PG8_BAR;
            PG8_LDB(B0, 1, 0); PG8_SCHED; PG8_LDA(At, 1, 0); PG8_STAGE(PG8_SA(0, 1), a2 + hstepA, voffA);
            PG8_WAIT_L(8); PG8_BAR; PG8_WAIT_L(0); PG8_MMA(0, 0, At, B0); PG8_BAR; PG8_SCHED;
            PG8_LDB(B1, 1, 1); PG8_STAGE(PG8_SB(1, 0), b3, voffB);
            PG8_BAR; PG8_WAIT_L(0); PG8_MMA(0, 1, At, B1); PG8_BAR;
            PG8_LDA(At, 1, 1); PG8_STAGE(PG8_SA(1, 0), a3, voffA);
            PG8_BAR; PG8_WAIT_L(0); PG8_MMA(1, 0, At, B0); PG8_BAR; PG8_SCHED;
            PG8_STAGE(PG8_SB(1, 1), b3 + hstepB, voffB);
            PG8_WAIT_V(6); PG8_BAR; PG8_MMA(1, 1, At, B1); PG8_BAR;
            }
        }
        if constexpr (ALIGN_EPI) { if (wr == 0) PG8_BAR; }
        if constexpr (!Epi::AFTER_DRAIN) { E(acc, cur, wr, wc, fr, fq); S.done(cur); }
        if (!has_next) break;
#pragma unroll
        for (int a = 0; a < 2; ++a)
#pragma unroll
            for (int b = 0; b < 2; ++b)
#pragma unroll
                for (int m = 0; m < 4; ++m)
#pragma unroll
                    for (int n = 0; n < 2; ++n) acc[a][b][m][n] = (f32x4){0.f, 0.f, 0.f, 0.f};
        cur = nxt; cA = nA; cB = nB; ++ui;
        if constexpr (ALIGN_EPI) { if (wr == 1) PG8_BAR; }
    }
    PG8_WAIT_V(0);
    if constexpr (!ALIGN_EPI) { if (wr == 0) PG8_BAR; }
    PG8_BAR;
    if constexpr (Epi::AFTER_DRAIN) { E.fused(acc, cur, wr, wc, fr, fq, lds, wid, lane); S.done(cur); }
#undef PG8_SA
#undef PG8_SB
#undef PG8_STAGE
#undef PG8_LDA
#undef PG8_LDB
#undef PG8_MMA
#undef PG8_WAIT_V
#undef PG8_WAIT_L
#undef PG8_BAR
#undef PG8_SCHED
}
}
namespace att {
typedef unsigned short bf16_t;
typedef short bf16x8 __attribute__((ext_vector_type(8)));
typedef short s16x4 __attribute__((ext_vector_type(4)));
typedef float f32x16 __attribute__((ext_vector_type(16)));
typedef unsigned u32x4 __attribute__((ext_vector_type(4)));
typedef unsigned u32x2 __attribute__((ext_vector_type(2)));
#define ATT_LAS __attribute__((address_space(3)))
constexpr int VP = 320;
constexpr int KBUF_BYTES = 64 * 400, VBUF_BYTES = 64 * VP;
constexpr int L_K0 = 0, L_V0 = 2 * KBUF_BYTES, L_LUT = L_V0 + 3 * VBUF_BYTES, L_Q = L_LUT + 512;
__device__ __forceinline__ int crow(int r, int hi) { return (r & 3) + 8 * (r >> 2) + 4 * hi; }
__device__ __forceinline__ unsigned pk2(float lo, float hi) { unsigned r; asm volatile("v_cvt_pk_bf16_f32 %0, %1, %2" : "=v"(r) : "v"(lo), "v"(hi)); return r; }
__device__ __forceinline__ float bf2f(short s) { return __uint_as_float(((unsigned)(unsigned short)s) << 16); }
__device__ __forceinline__ s16x4 vtr(const ATT_LAS unsigned char* p) { typedef short v4i16_t __attribute__((ext_vector_type(4))); return __builtin_bit_cast(s16x4, __builtin_amdgcn_ds_read_tr16_b64_v4i16((ATT_LAS v4i16_t*)p)); }
__device__ __forceinline__ int t5_bucket(int n) {
    if (n < 16) return n;
    const float v = logf((float)n / 16.0f) / 2.0794415416798357f * 16.0f;
    int b = 16 + (int)v; return b < 31 ? b : 31;
}
__device__ __forceinline__ void rope_cs(int pos, int i, float& c, float& s) {
    const float inv = exp2f(-(float)i * (13.287712379549449f / 32.0f));
    const float ang = (float)pos * inv;
    const double t = (double)ang * 0.15915494309189535; const float fr = (float)(t - floor(t));
    s = __builtin_amdgcn_sinf(fr); c = __builtin_amdgcn_cosf(fr);
}

template <int DQK, bool BIAS, bool MLA>
__device__ __forceinline__ void flash_pass(ATT_LAS unsigned char* lds, const bf16_t* __restrict__ Qp, int ldq, const bf16_t* __restrict__ Kp, int ldk, const bf16_t* __restrict__ K2p,
                                           const bf16_t* __restrict__ Vp, int ldv, const bf16_t* __restrict__ Kmp, const bf16_t* __restrict__ K2mp, const bf16_t* __restrict__ Vmp, int Q0, float sc2, f32x16 (&o)[4]) {
    constexpr int KP = DQK * 2 + 16, NS = DQK / 16, KCH = DQK / 8;
    const int tid = threadIdx.x, lane = tid & 63, wid = __builtin_amdgcn_readfirstlane(tid >> 6), r32 = lane & 31, hi = lane >> 5;
    const int q0w = 64 + Q0 + 32 * wid, qpos = q0w + r32, qld = qpos - 64;
    const ATT_LAS float* lut = (const ATT_LAS float*)(lds + L_LUT);
    bf16x8 qf[NS];
#pragma unroll
    for (int s = 0; s < NS; ++s) qf[s] = *(const bf16x8*)(Qp + (size_t)qld * ldq + 16 * s + 8 * hi);
    if (MLA) {
#pragma unroll
        for (int s = 8; s < 10; ++s)
#pragma unroll
            for (int j = 0; j < 8; ++j) { float c, sn; rope_cs(qld + 16, 16 * (s - 8) + 8 * hi + j, c, sn);
                const float x1 = bf2f(qf[s][j]), x2 = bf2f(qf[s + 2][j]); const unsigned w = pk2(x1 * c - x2 * sn, x1 * sn + x2 * c);
                qf[s][j] = (short)(w & 0xffffu); qf[s + 2][j] = (short)(w >> 16); }
    }
#pragma unroll
    for (int c = 0; c < 4; ++c)
#pragma unroll
        for (int r = 0; r < 16; ++r) o[c][r] = 0.f;
    float mrun = -INFINITY, lsum = 0.f;
    const int NT = Q0 / 64 + 5;
    constexpr int KCPR = KCH + 1, NKI = KCPR, NVI = 20;
    constexpr int NPW = (NKI + NVI + 7) / 8;
    unsigned poff[NPW];
#pragma unroll
    for (int i = 0; i < NPW; ++i) { const int pc = wid + 8 * i;
        if (pc < NKI) { const int L = 64 * pc + lane, row = L / KCPR, ch = L - row * KCPR;
            poff[i] = (MLA && ch >= 16 && ch < 24) ? (0x80000000u | (unsigned)(row * 64 + 8 * (ch - 16)) * 2u) : (unsigned)(row * ldk + 8 * (ch < (MLA ? 16 : KCH) ? ch : 0)) * 2u; }
        else { const int L = 64 * (pc - NKI) + lane, row = L / 20, ch = L - row * 20; poff[i] = (unsigned)(row * ldv + 8 * (ch < 16 ? ch : 0)) * 2u; } }
    auto issue = [&](int kt, int kslot, int vslot) __attribute__((always_inline)) {
        const char* kbase = (const char*)(kt == 0 ? Kmp : Kp + (size_t)(64 * (kt - 1)) * ldk);
        const char* vbase = (const char*)(kt == 0 ? Vmp : Vp + (size_t)(64 * (kt - 1)) * ldv);
        const char* k2base = MLA ? (const char*)(kt == 0 ? K2mp : K2p + (size_t)(64 * (kt - 1)) * 64) : nullptr;
#pragma unroll
        for (int i = 0; i < NPW; ++i) { const int pc = wid + 8 * i;
            if (pc < NKI) { const char* src = (MLA && (poff[i] >> 31)) ? k2base + (poff[i] & 0x7fffffffu) : kbase + poff[i];
                __builtin_amdgcn_global_load_lds((const unsigned*)src, (ATT_LAS unsigned*)(lds + L_K0 + kslot * KBUF_BYTES + pc * 1024), 16, 0, 0); }
            else if (pc < NKI + NVI) __builtin_amdgcn_global_load_lds((const unsigned*)(vbase + poff[i]), (ATT_LAS unsigned*)(lds + L_V0 + vslot * VBUF_BYTES + (pc - NKI) * 1024), 16, 0, 0); }
    };
    const int vlane = (4 * hi + ((lane & 15) >> 2)) * VP + (16 * ((lane >> 4) & 1) + 4 * (lane & 3)) * 2;
    u32x4 pw[4];
    auto qk_softmax = [&](int kt, int kslot) __attribute__((always_inline)) {
        const int k0 = 64 * kt;
        f32x16 p0, p1;
#pragma unroll
        for (int r = 0; r < 16; ++r) { p0[r] = 0.f; p1[r] = 0.f; }
        const ATT_LAS unsigned char* kb = lds + L_K0 + kslot * KBUF_BYTES + r32 * KP + hi * 16;
#pragma unroll
        for (int s = 0; s < NS; ++s) { const bf16x8 a0 = *(const ATT_LAS bf16x8*)(kb + s * 32), a1 = *(const ATT_LAS bf16x8*)(kb + 32 * KP + s * 32);
            p0 = __builtin_amdgcn_mfma_f32_32x32x16_bf16(a0, qf[s], p0, 0, 0, 0); p1 = __builtin_amdgcn_mfma_f32_32x32x16_bf16(a1, qf[s], p1, 0, 0, 0); }
        const bool edge = (k0 + 63 > q0w) || (kt == 0) || (BIAS && (q0w - (k0 + 63) < 113));
        float SC = sc2, C0 = BIAS ? lut[127] : 0.f;
        if (edge) {
#pragma unroll
            for (int r = 0; r < 16; ++r) {
                const int kp0 = k0 + crow(r, hi), kp1 = kp0 + 32; const int rel0 = qpos - kp0, rel1 = qpos - kp1;
                float s0 = p0[r] * sc2, s1 = p1[r] * sc2;
                if (BIAS) { s0 += lut[rel0 < 0 ? 0 : (rel0 > 127 ? 127 : rel0)]; s1 += lut[rel1 < 0 ? 0 : (rel1 > 127 ? 127 : rel1)]; }
                p0[r] = (rel0 >= 0 && kp0 >= 48) ? s0 : -INFINITY; p1[r] = (rel1 >= 0 && kp1 >= 48) ? s1 : -INFINITY;
            }
            SC = 1.f; C0 = 0.f;
        }
        float mx = fmaxf(p0[0], p1[0]);
#pragma unroll
        for (int r = 1; r < 16; ++r) mx = fmaxf(mx, fmaxf(p0[r], p1[r]));
        mx = fmaxf(mx, __shfl_xor(mx, 32)) * SC + C0;
        const float mnew = (mx > mrun + 8.0f) ? mx : mrun, muse = (mnew == -INFINITY) ? 0.f : mnew;
        const float alpha = __builtin_amdgcn_exp2f(mrun - muse); mrun = mnew;
        const float c0 = C0 - muse; float ps = 0.f;
#pragma unroll
        for (int r = 0; r < 16; ++r) { p0[r] = __builtin_amdgcn_exp2f(__builtin_fmaf(p0[r], SC, c0)); p1[r] = __builtin_amdgcn_exp2f(__builtin_fmaf(p1[r], SC, c0)); ps += p0[r] + p1[r]; }
        lsum = lsum * alpha + ps;
        if (__any(alpha != 1.f)) {
#pragma unroll
            for (int c = 0; c < 4; ++c)
#pragma unroll
                for (int r = 0; r < 16; ++r) o[c][r] *= alpha;
        }
#pragma unroll
        for (int s2 = 0; s2 < 2; ++s2) {
            pw[s2] = (u32x4){pk2(p0[8 * s2 + 0], p0[8 * s2 + 1]), pk2(p0[8 * s2 + 2], p0[8 * s2 + 3]), pk2(p0[8 * s2 + 4], p0[8 * s2 + 5]), pk2(p0[8 * s2 + 6], p0[8 * s2 + 7])};
            pw[2 + s2] = (u32x4){pk2(p1[8 * s2 + 0], p1[8 * s2 + 1]), pk2(p1[8 * s2 + 2], p1[8 * s2 + 3]), pk2(p1[8 * s2 + 4], p1[8 * s2 + 5]), pk2(p1[8 * s2 + 6], p1[8 * s2 + 7])};
        }
    };
    auto pv = [&](int vslot) __attribute__((always_inline)) {
        const ATT_LAS unsigned char* vb = lds + L_V0 + vslot * VBUF_BYTES + vlane;
#pragma unroll
        for (int sl = 0; sl < 4; ++sl) {
            const bf16x8 pf = __builtin_bit_cast(bf16x8, pw[sl]);
#pragma unroll
            for (int c = 0; c < 4; ++c) {
                const s16x4 lo = vtr(vb + (16 * sl) * VP + c * 64), hh = vtr(vb + (16 * sl + 8) * VP + c * 64);
                const bf16x8 vf = (bf16x8){lo[0], lo[1], lo[2], lo[3], hh[0], hh[1], hh[2], hh[3]};
                o[c] = __builtin_amdgcn_mfma_f32_32x32x16_bf16(vf, pf, o[c], 0, 0, 0);
            }
        }
    };
    constexpr bool SKEW = false;
    const bool late = SKEW && !MLA && wid >= 4;
    issue(0, 0, 0); asm volatile("s_waitcnt vmcnt(0)" ::: "memory"); __syncthreads();
    int vs_prev = 2, vs_cur = 0, vs_next = 1;
    for (int kt = 0; kt < NT + (SKEW && !MLA ? 1 : 0); ++kt) {
        if (kt + 1 < NT) issue(kt + 1, (kt + 1) & 1, vs_next);
        const bool act = kt < NT && 64 * kt <= q0w + 31;
        if (late && kt > 0 && 64 * (kt - 1) <= q0w + 31) pv(vs_prev);
        if (act) qk_softmax(kt, kt & 1);
        if (!late && act) pv(vs_cur);
        asm volatile("s_waitcnt vmcnt(0)" ::: "memory"); __syncthreads();
        const int t = vs_prev; vs_prev = vs_cur; vs_cur = vs_next; vs_next = t;
    }
    const float lt = lsum + __shfl_xor(lsum, 32);
    const float inv = lt > 0.f ? 1.f / lt : 0.f;
#pragma unroll
    for (int c = 0; c < 4; ++c)
#pragma unroll
        for (int r = 0; r < 16; ++r) o[c][r] *= inv;
}

struct AttnArgs {
    const bf16_t* daqkv; const bf16_t* qmla; const bf16_t* kvmla; const bf16_t* kr; const bf16_t* m_daqkv; const bf16_t* m_kvmla; const bf16_t* m_kr; bf16_t* yda; bf16_t* ymla;
    const float* table; const float* subg; const float* lq1; const float* lk1; const float* lq2; const float* lk2; int* counter;
};
template <int TYPE> __device__ __forceinline__ void attn_units(ATT_LAS unsigned char* lds, const AttnArgs& A) {
    const int tid = threadIdx.x, lane = tid & 63, wid = __builtin_amdgcn_readfirstlane(tid >> 6), r32 = lane & 31, hi = lane >> 5;
    ATT_LAS int* qslot = (ATT_LAS int*)(lds + L_Q);
    ATT_LAS float* lut = (ATT_LAS float*)(lds + L_LUT);
    constexpr int NJ = 32, TOTAL = NJ * 16;
    for (;;) {
        __syncthreads();
        if (tid == 0) *qslot = atomicAdd(A.counter + TYPE, 1);
        __syncthreads();
        const int u = *qslot;
        if (u >= TOTAL) break;
        const int j = NJ - 1 - (u >> 4), rem = u & 15, b = rem >> 3, h = rem & 7;
        const int Q0 = 256 * j; const size_t brow = (size_t)b * SEQ;
        const int qpos = Q0 + 32 * wid + r32;
        f32x16 o[4];
        if (TYPE == 0) {
            float lam;
            { float a = A.lq1[lane] * A.lk1[lane], bb = A.lq2[lane] * A.lk2[lane];
#pragma unroll
              for (int off = 1; off < 64; off <<= 1) { a += __shfl_xor(a, off); bb += __shfl_xor(bb, off); }
              lam = expf(a) - expf(bb) + 0.2f; }
            if (tid < 128) lut[tid] = A.table[t5_bucket(tid) * 8 + h] * LOG2E;
            bf16_t* orow = A.yda + (brow + qpos) * 1024 + h * 128;
#pragma unroll
            for (int comp = 0; comp < 2; ++comp) {
                const bf16_t* base = A.daqkv + brow * 3072 + h * 128;
                const bf16_t* mb = A.m_daqkv + h * 128;
                flash_pass<64, true, false>(lds, base + comp * 64, 3072, base + 1024 + comp * 64, 3072, nullptr, base + 2048, 3072, mb + 1024 + comp * 64, nullptr, mb + 2048, Q0, 0.125f * LOG2E, o);
                if (comp == 0) {
#pragma unroll
                    for (int c = 0; c < 4; ++c)
#pragma unroll
                        for (int g4 = 0; g4 < 4; ++g4) { u32x2 w; w.x = pk2(o[c][4 * g4 + 0], o[c][4 * g4 + 1]); w.y = pk2(o[c][4 * g4 + 2], o[c][4 * g4 + 3]); *(u32x2*)(orow + 32 * c + 8 * g4 + 4 * hi) = w; }
                }
            }
            float ss = 0.f;
#pragma unroll
            for (int c = 0; c < 4; ++c)
#pragma unroll
                for (int g4 = 0; g4 < 4; ++g4) { const u32x2 w = *(const u32x2*)(orow + 32 * c + 8 * g4 + 4 * hi);
                    const float y0 = __uint_as_float(w.x << 16) - lam * o[c][4 * g4 + 0], y1 = __uint_as_float(w.x & 0xffff0000u) - lam * o[c][4 * g4 + 1];
                    const float y2 = __uint_as_float(w.y << 16) - lam * o[c][4 * g4 + 2], y3 = __uint_as_float(w.y & 0xffff0000u) - lam * o[c][4 * g4 + 3];
                    o[c][4 * g4 + 0] = y0; o[c][4 * g4 + 1] = y1; o[c][4 * g4 + 2] = y2; o[c][4 * g4 + 3] = y3; ss += (y0 * y0 + y1 * y1) + (y2 * y2 + y3 * y3); }
            ss += __shfl_xor(ss, 32);
            const float rstd = __builtin_amdgcn_rsqf(ss * (1.f / 128.f) + RMS_EPS) * 0.8f;
            {
#pragma unroll
                for (int c = 0; c < 4; ++c)
#pragma unroll
                    for (int g4 = 0; g4 < 4; ++g4) { const int d0 = 32 * c + 8 * g4 + 4 * hi; const float4 gv = *(const float4*)(A.subg + d0);
                        u32x2 w; w.x = pk2(o[c][4 * g4 + 0] * rstd * gv.x, o[c][4 * g4 + 1] * rstd * gv.y); w.y = pk2(o[c][4 * g4 + 2] * rstd * gv.z, o[c][4 * g4 + 3] * rstd * gv.w);
                        *(u32x2*)(orow + d0) = w; }
            }
        } else {
            flash_pass<192, false, true>(lds, A.qmla + brow * 1536 + h * 192, 1536, A.kvmla + brow * 2048 + h * 256, 2048, A.kr + brow * 64, A.kvmla + brow * 2048 + h * 256 + 128, 2048,
                                         A.m_kvmla + h * 256, A.m_kr, A.m_kvmla + h * 256 + 128, Q0,
                                         0.07216878364870322f * LOG2E, o);
            {
                bf16_t* orow = A.ymla + (brow + qpos) * 1024 + h * 128;
#pragma unroll
                for (int c = 0; c < 4; ++c)
#pragma unroll
                    for (int g4 = 0; g4 < 4; ++g4) { const int d0 = 32 * c + 8 * g4 + 4 * hi;
                        u32x2 w; w.x = pk2(o[c][4 * g4 + 0], o[c][4 * g4 + 1]); w.y = pk2(o[c][4 * g4 + 2], o[c][4 * g4 + 3]);
                        *(u32x2*)(orow + d0) = w; }
            }
        }
    }
}
__device__ __forceinline__ void attn_phase(ATT_LAS unsigned char* lds, const AttnArgs& A) {
#ifndef ATT_TYPES
#define ATT_TYPES 3
#endif
    if (ATT_TYPES & 1) attn_units<0>(lds, A);
    if (ATT_TYPES & 2) attn_units<1>(lds, A);
}
}
typedef unsigned short bf16_t;
typedef float f32x4 __attribute__((ext_vector_type(4)));
typedef unsigned u32x4 __attribute__((ext_vector_type(4)));
typedef unsigned u32x2 __attribute__((ext_vector_type(2)));
#define LAS __attribute__((address_space(3)))

#define XB_TMO      128
#define XB_XCNT(j)  (256  + 64 * (j))
#define XB_XSUB(j)  (1280 + 64 * (j))
#define XB_XGEN(j)  (2304 + 64 * (j))
#define XB_TOP      3328
#define XB_TOPGEN   3392
#define XCD_BAR_WORDS 3456
#define XB_SPIN_CAP (1u << 18)

__device__ __forceinline__ unsigned xb_ld(unsigned* p)              { return __hip_atomic_load(p, __ATOMIC_RELAXED, __HIP_MEMORY_SCOPE_AGENT); }
__device__ __forceinline__ unsigned xb_add(unsigned* p, unsigned v) { return __hip_atomic_fetch_add(p, v, __ATOMIC_RELAXED, __HIP_MEMORY_SCOPE_AGENT); }
__device__ __forceinline__ unsigned xb_xcc_id() { return (unsigned)__builtin_amdgcn_s_getreg((3 << 11) | 20) & 0xFu; }
#define XB_SPIN(cond, bar) do { unsigned _sp = 0; while (cond) { __builtin_amdgcn_s_sleep(1); \
    if ((++_sp & 255u) == 0u) { if (xb_ld(&(bar)[XB_TMO])) break; if (_sp > XB_SPIN_CAP) { atomicAdd(&(bar)[XB_TMO], 1u); break; } } } } while (0)

struct XcdBarrier {
    unsigned* bar; unsigned x;
    volatile LAS unsigned* st;
};

__device__ __forceinline__ XcdBarrier xcd_barrier_post(unsigned* bar, volatile LAS unsigned* st) {
    XcdBarrier b; b.bar = bar; b.x = xb_xcc_id(); b.st = st;
    if (threadIdx.x == 0) (void)xb_add(&bar[XB_XCNT(b.x)], 1u);
    return b;
}
__device__ __forceinline__ void xcd_barrier_complete(unsigned* bar, unsigned x, unsigned& nloc, unsigned& nx) {
    const unsigned G = gridDim.x * gridDim.y * gridDim.z;
    unsigned sum, cnt, mine, sp = 0u;
    for (;;) {
        sum = 0u; cnt = 0u; mine = 0u;
#pragma unroll
        for (unsigned j = 0; j < 16; ++j) { const unsigned c = xb_ld(&bar[XB_XCNT(j)]); sum += c; cnt += (c > 0u) ? 1u : 0u; mine = (j == x) ? c : mine; }
        if (sum == G) break;
        __builtin_amdgcn_s_sleep(1);
        if ((++sp & 255u) == 0u) { if (xb_ld(&bar[XB_TMO])) break; if (sp > XB_SPIN_CAP) { atomicAdd(&bar[XB_TMO], 1u); break; } }
    }
    nloc = mine > 0u ? mine : 1u; nx = cnt > 0u ? cnt : 1u;
}

__device__ __forceinline__ void xcd_barrier(const XcdBarrier& b) {
    asm volatile("s_waitcnt vmcnt(0)" ::: "memory");
    __syncthreads();
    if (threadIdx.x == 0) {
        unsigned* bar = b.bar;
        __builtin_amdgcn_s_waitcnt(0);
        unsigned nloc = b.st[0], nx = b.st[1];
        if (nloc == 0u) { xcd_barrier_complete(bar, b.x, nloc, nx); b.st[0] = nloc; b.st[1] = nx; }
        const unsigned old = xb_add(&bar[XB_XSUB(b.x)], 1u);
        const unsigned gen = old / nloc;
        if (old + 1u == (gen + 1u) * nloc) {
            __builtin_amdgcn_fence(__ATOMIC_RELEASE, "agent");
            asm volatile("s_waitcnt vmcnt(0)" ::: "memory");
            const unsigned og = xb_add(&bar[XB_TOP], 1u);
            const unsigned tg = og / nx;
            if (og + 1u == (tg + 1u) * nx) xb_add(&bar[XB_TOPGEN], 1u);
            else XB_SPIN(xb_ld(&bar[XB_TOPGEN]) == tg, bar);
            __builtin_amdgcn_fence(__ATOMIC_ACQUIRE, "agent");
            xb_add(&bar[XB_XGEN(b.x)], 1u);
            asm volatile("s_waitcnt vmcnt(0)" ::: "memory");
        } else {
            XB_SPIN(xb_ld(&bar[XB_XGEN(b.x)]) == gen, bar);
            __builtin_amdgcn_fence(__ATOMIC_ACQUIRE, "agent");
            asm volatile("s_waitcnt vmcnt(0)" ::: "memory");
        }
    }
    __syncthreads();
}


struct Params {
    const float* in[29];
    float* out; unsigned char* ws;
    int ph_lo, ph_hi;
};
enum { I_X = 0, I_META, I_TABLE, I_F1PRE, I_F1POST, I_F1G, I_F1U, I_F1D, I_MIXPRE, I_MIXPOST, I_WIN, I_BGATE, I_LQ1, I_LK1, I_LQ2, I_LK2, I_SUBG, I_QNG, I_KVNG, I_WUQ, I_WUKV,
       I_WBDA, I_WBMLA, I_WOUT, I_F2PRE, I_F2POST, I_F2G, I_F2U, I_F2D };

__device__ __forceinline__ float wave_sum(float v) {
#pragma unroll
    for (int o = 1; o < 64; o <<= 1) v += __shfl_xor(v, o);
    return v;
}
__device__ __forceinline__ unsigned pkbf(float lo, float hi) { unsigned r; asm volatile("v_cvt_pk_bf16_f32 %0, %1, %2" : "=v"(r) : "v"(lo), "v"(hi)); return r; }

struct CvtJob { const float* src; bf16_t* dst; const float* kscale; int K, N, mode; };
__device__ __forceinline__ int cvt_maprow(int mode, int n) {
    if (mode == 1) return 256 * (n >> 7) + (n & 127);
    if (mode == 2) return 256 * (n >> 7) + 128 + (n & 127);
    if (mode == 3) return n < 4416 ? n + 4096 : n - 4416;
    return n;
}
__device__ __forceinline__ void cvt_load(const CvtJob& jb, int t, f32x4 (&a)[8]) {
    const int lane = threadIdx.x & 63, nbn = jb.N >> 5, kb = t / nbn, nb = t - kb * nbn, k0 = kb * 64, n0 = nb * 32, rr = lane >> 3, c4 = (lane & 7) * 4;
#pragma unroll
    for (int i = 0; i < 8; ++i) a[i] = __builtin_nontemporal_load((const f32x4*)(jb.src + (size_t)(k0 + 8 * i + rr) * jb.N + n0 + c4));
}
__device__ __forceinline__ void cvt_finish(const CvtJob& jb, int t, const f32x4 (&a)[8], LAS float* scr) {
    const int lane = threadIdx.x & 63, nbn = jb.N >> 5, kb = t / nbn, nb = t - kb * nbn, k0 = kb * 64, n0 = nb * 32;
    { const int rr = lane >> 3, c4 = (lane & 7) * 4;
#pragma unroll
      for (int i = 0; i < 8; ++i) { const int k = 8 * i + rr; const float sc = jb.kscale ? jb.kscale[k0 + k] : 1.f;
          LAS float* d = scr + k * 33 + c4; d[0] = a[i][0] * sc; d[1] = a[i][1] * sc; d[2] = a[i][2] * sc; d[3] = a[i][3] * sc; } }
    asm volatile("s_waitcnt lgkmcnt(0)" ::: "memory");
    { const int kc = (lane & 7) * 8;
#pragma unroll
      for (int j = 0; j < 4; ++j) { const int nn = (lane >> 3) + 8 * j; const LAS float* s = scr + kc * 33 + nn;
          u32x4 w; w.x = pkbf(s[0], s[33]); w.y = pkbf(s[66], s[99]); w.z = pkbf(s[132], s[165]); w.w = pkbf(s[198], s[231]);
          *(u32x4*)(jb.dst + (size_t)cvt_maprow(jb.mode, n0 + nn) * jb.K + k0 + kc) = w; } }
    asm volatile("s_waitcnt lgkmcnt(0)" ::: "memory");
}
__device__ __forceinline__ CvtJob cvt_job(const Params& p, int j) {
    unsigned char* ws = p.ws; CvtJob r;
    switch (j) {
    case 0: r = CvtJob{p.in[I_WIN], (bf16_t*)(ws + OFF_WIN), nullptr, 2048, 8512, 3}; break;
    case 1: r = CvtJob{p.in[I_WUQ], (bf16_t*)(ws + OFF_WUQ), p.in[I_QNG], 768, 1536, 0}; break;
    case 2: r = CvtJob{p.in[I_WUKV], (bf16_t*)(ws + OFF_WUKV), p.in[I_KVNG], 512, 2048, 0}; break;
    case 3: r = CvtJob{p.in[I_WBDA], (bf16_t*)(ws + OFF_WBDA), nullptr, 1024, 2048, 0}; break;
    case 4: r = CvtJob{p.in[I_WBMLA], (bf16_t*)(ws + OFF_WBMLA), nullptr, 1024, 2048, 0}; break;
    case 5: r = CvtJob{p.in[I_WOUT], (bf16_t*)(ws + OFF_WOUT), nullptr, 2048, 2048, 0}; break;
    case 6: r = CvtJob{p.in[I_F1G], (bf16_t*)(ws + OFF_FFN), nullptr, 2048, 5632, 1}; break;
    case 7: r = CvtJob{p.in[I_F1U], (bf16_t*)(ws + OFF_FFN), nullptr, 2048, 5632, 2}; break;
    case 8: r = CvtJob{p.in[I_F1D], (bf16_t*)(ws + OFF_WD), nullptr, 5632, 2048, 0}; break;
    case 9: r = CvtJob{p.in[I_F2G], (bf16_t*)(ws + OFF_FFN), nullptr, 2048, 5632, 1}; break;
    case 10: r = CvtJob{p.in[I_F2U], (bf16_t*)(ws + OFF_FFN), nullptr, 2048, 5632, 2}; break;
    default: r = CvtJob{p.in[I_F2D], (bf16_t*)(ws + OFF_WD), nullptr, 5632, 2048, 0}; break;
    }
    return r;
}
template <int JLO, int JHI> __device__ __forceinline__ void cvt_jobs(const Params& p, LAS float* tile) {
    const int wid = threadIdx.x >> 6, nw = (int)gridDim.x * 8, gw = (int)blockIdx.x * 8 + wid;
    LAS float* scr = tile + wid * (64 * 33);
    int base = 0;
#pragma unroll
    for (int j = JLO; j < JHI; ++j) {
        const CvtJob jb = cvt_job(p, j); const int nt = (jb.K >> 6) * (jb.N >> 5);
        int t = (gw - base % nw + nw) % nw;
        f32x4 ra[8], rb[8];
        if (t < nt) cvt_load(jb, t, ra);
        for (; t < nt; t += 2 * nw) {
            const int t1 = t + nw, t2 = t + 2 * nw;
            if (t1 < nt) cvt_load(jb, t1, rb);
            cvt_finish(jb, t, ra, scr);
            if (t1 < nt) { if (t2 < nt) cvt_load(jb, t2, ra); cvt_finish(jb, t1, rb, scr); }
        }
        base += nt;
    }
    __syncthreads();
}

__device__ __forceinline__ void norm_rows(const Params& p, bool src_input, const bf16_t* f, float coef, const float* gpost, const float* gnext) {
    const int lane = threadIdx.x & 63, wid = threadIdx.x >> 6;
    bf16_t* HN = (bf16_t*)(p.ws + OFF_HN);
    for (int row = blockIdx.x * 8 + wid; row < MROWS; row += gridDim.x * 8) {
        const float* hsrc = (src_input ? p.in[I_X] : p.out) + (size_t)row * D;
        f32x4 hv[8];
#pragma unroll
        for (int i = 0; i < 8; ++i) hv[i] = __builtin_nontemporal_load((const f32x4*)hsrc + lane + 64 * i);
        if (f) {
            f32x4 fv[8]; float ss = 0.f;
#pragma unroll
            for (int i = 0; i < 8; ++i) { const u32x2 w = __builtin_nontemporal_load((const u32x2*)(f + (size_t)row * D) + lane + 64 * i); fv[i] = (f32x4){__uint_as_float(w.x << 16), __uint_as_float(w.x & 0xffff0000u), __uint_as_float(w.y << 16), __uint_as_float(w.y & 0xffff0000u)};
                ss += (fv[i][0] * fv[i][0] + fv[i][1] * fv[i][1]) + (fv[i][2] * fv[i][2] + fv[i][3] * fv[i][3]); }
            const float r = coef * __builtin_amdgcn_rsqf(wave_sum(ss) * (1.f / D) + RMS_EPS);
#pragma unroll
            for (int i = 0; i < 8; ++i) { const f32x4 g = ((const f32x4*)gpost)[lane + 64 * i]; hv[i] = hv[i] + fv[i] * g * r; }
            float* hd = p.out + (size_t)row * D;
#pragma unroll
            for (int i = 0; i < 8; ++i) { if (gnext) ((f32x4*)hd)[lane + 64 * i] = hv[i]; else __builtin_nontemporal_store(hv[i], (f32x4*)hd + lane + 64 * i); }
        }
        if (gnext) {
            float ss = 0.f;
#pragma unroll
            for (int i = 0; i < 8; ++i) ss += (hv[i][0] * hv[i][0] + hv[i][1] * hv[i][1]) + (hv[i][2] * hv[i][2] + hv[i][3] * hv[i][3]);
            const float r = __builtin_amdgcn_rsqf(wave_sum(ss) * (1.f / D) + RMS_EPS);
            u32x2* o = (u32x2*)(HN + (size_t)row * D);
#pragma unroll
            for (int i = 0; i < 8; ++i) { const f32x4 g = ((const f32x4*)gnext)[lane + 64 * i]; const f32x4 v = hv[i] * g * r; o[lane + 64 * i] = (u32x2){pkbf(v[0], v[1]), pkbf(v[2], v[3])}; }
        }
    }
}
__device__ __forceinline__ void norm_meta(const Params& p, const float* f, const float* gpost, const float* gnext, bf16_t* HNM) {
    if (blockIdx.x != gridDim.x - 1) return;
    const int lane = threadIdx.x & 63, wid = threadIdx.x >> 6;
    for (int row = wid; row < 16; row += 8) {
        f32x4 hv[8];
#pragma unroll
        for (int i = 0; i < 8; ++i) hv[i] = ((const f32x4*)(p.in[I_META] + (size_t)row * D))[lane + 64 * i];
        if (f) {
            f32x4 fv[8]; float ss = 0.f;
#pragma unroll
            for (int i = 0; i < 8; ++i) { fv[i] = ((const f32x4*)(f + (size_t)row * D))[lane + 64 * i]; ss += (fv[i][0] * fv[i][0] + fv[i][1] * fv[i][1]) + (fv[i][2] * fv[i][2] + fv[i][3] * fv[i][3]); }
            const float r = 0.5f * __builtin_amdgcn_rsqf(wave_sum(ss) * (1.f / D) + RMS_EPS);
#pragma unroll
            for (int i = 0; i < 8; ++i) { const f32x4 g = ((const f32x4*)gpost)[lane + 64 * i]; hv[i] = hv[i] + fv[i] * g * r; }
        }
        float ss = 0.f;
#pragma unroll
        for (int i = 0; i < 8; ++i) ss += (hv[i][0] * hv[i][0] + hv[i][1] * hv[i][1]) + (hv[i][2] * hv[i][2] + hv[i][3] * hv[i][3]);
        const float r = __builtin_amdgcn_rsqf(wave_sum(ss) * (1.f / D) + RMS_EPS);
        u32x2* o = (u32x2*)(HNM + (size_t)row * D);
#pragma unroll
        for (int i = 0; i < 8; ++i) { const f32x4 g = ((const f32x4*)gnext)[lane + 64 * i]; const f32x4 v = hv[i] * g * r; o[lane + 64 * i] = (u32x2){pkbf(v[0], v[1]), pkbf(v[2], v[3])}; }
    }
}
__device__ __forceinline__ void rope_k_rows(const Params& p) {
    const bf16_t* cb = (const bf16_t*)(p.ws + OFF_CBUF); bf16_t* kr = (bf16_t*)(p.ws + OFF_KR);
    const bf16_t* cm = (const bf16_t*)(p.ws + OFF_M_C); bf16_t* krm = (bf16_t*)(p.ws + OFF_M_KR);
    const int total = (MROWS + 16) * 32;
    for (int idx = blockIdx.x * 512 + threadIdx.x; idx < total; idx += gridDim.x * 512) {
        const int row = idx >> 5, i = idx & 31; const bool meta = row >= MROWS;
        const int pos = meta ? row - MROWS : 16 + (row & (SEQ - 1));
        const bf16_t* src = meta ? cm + (size_t)(row - MROWS) * CP : cb + (size_t)row * CP;
        bf16_t* dst = meta ? krm + (size_t)(48 + row - MROWS) * 64 : kr + (size_t)row * 64;
        float c, sn; att::rope_cs(pos, i, c, sn);
        const float x1 = __uint_as_float((unsigned)src[1280 + i] << 16), x2 = __uint_as_float((unsigned)src[1312 + i] << 16);
        const unsigned w = pkbf(x1 * c - x2 * sn, x1 * sn + x2 * c);
        dst[i] = (bf16_t)(w & 0xffffu); dst[32 + i] = (bf16_t)(w >> 16);
    }
}
typedef short bf16x8_t __attribute__((ext_vector_type(8)));
template <int NACC, class F>
__device__ __forceinline__ void skinny_block(LAS unsigned char* lds, const bf16_t* A, int lda, const bf16_t* B0, const bf16_t* B1, int ldb, int K, F&& f) {
    const int lane = threadIdx.x & 63, wid = threadIdx.x >> 6, fr = lane & 15, fq = lane >> 4, kw = K >> 3;
    const bf16_t* ap = A + (size_t)fr * lda + wid * kw + 8 * fq;
    const bf16_t* bp0 = B0 + (size_t)fr * ldb + wid * kw + 8 * fq; const bf16_t* bp1 = B1 + (size_t)fr * ldb + wid * kw + 8 * fq;
    f32x4 acc0[4], acc1[4];
#pragma unroll
    for (int c = 0; c < 4; ++c) { acc0[c] = (f32x4){0.f, 0.f, 0.f, 0.f}; acc1[c] = acc0[c]; }
    for (int k = 0; k < kw; k += 32) {
        const bf16x8_t a = *(const bf16x8_t*)(ap + k);
#pragma unroll
        for (int c = 0; c < 4; ++c) {
            const bf16x8_t b0 = *(const bf16x8_t*)(bp0 + (size_t)(16 * c) * ldb + k);
            acc0[c] = __builtin_amdgcn_mfma_f32_16x16x32_bf16(a, b0, acc0[c], 0, 0, 0);
            if (NACC == 2) { const bf16x8_t b1 = *(const bf16x8_t*)(bp1 + (size_t)(16 * c) * ldb + k); acc1[c] = __builtin_amdgcn_mfma_f32_16x16x32_bf16(a, b1, acc1[c], 0, 0, 0); }
        }
    }
    LAS f32x4* red = (LAS f32x4*)lds;
#pragma unroll
    for (int c = 0; c < 4; ++c) { red[(c * 8 + wid) * 64 + lane] = acc0[c]; if (NACC == 2) red[((4 + c) * 8 + wid) * 64 + lane] = acc1[c]; }
    __syncthreads();
    if (wid == 0) {
#pragma unroll
        for (int c = 0; c < 4; ++c) {
            f32x4 s0 = red[(c * 8) * 64 + lane];
#pragma unroll
            for (int w = 1; w < 8; ++w) s0 = s0 + red[(c * 8 + w) * 64 + lane];
            acc0[c] = s0;
            if (NACC == 2) { f32x4 s1 = red[((4 + c) * 8) * 64 + lane];
#pragma unroll
                for (int w = 1; w < 8; ++w) s1 = s1 + red[((4 + c) * 8 + w) * 64 + lane];
                acc1[c] = s1; }
        }
        f(acc0, acc1, fr, 4 * fq);
    }
    __syncthreads();
}
#define SKINNY_FOR(blk, nblk) for (int blk = (int)gridDim.x - 1 - (int)blockIdx.x; blk < (nblk); blk += (int)gridDim.x)

template <class Epi> __device__ __forceinline__ void run_gemm(LAS unsigned char* lds, const bf16_t* A, int lda, const bf16_t* Bt, int ldb, int N, int K, const Epi& E) {
    pg8::Gemm g{A, Bt, MROWS, N, K, lda, ldb}; pg8::StaticOrder S; S.init(MROWS, N, gridDim.x, blockIdx.x);
    pg8::gemm_phase<Epi, pg8::StaticOrder, true, true>(lds, g, S, E);
}

#ifndef USE_GRID_SYNC
#define USE_GRID_SYNC 1
#endif
constexpr int NPHASE = 13;
constexpr int LDS_BYTES = 132096;

__global__ void __launch_bounds__(512, 2) fwd_kernel(Params p) {
    extern __shared__ __attribute__((aligned(16))) unsigned char lds_raw[];
    LAS unsigned char* lds = (LAS unsigned char*)lds_raw;
    unsigned char* ws = p.ws;
#define HN ((bf16_t*)(ws + OFF_HN))
#define FB ((bf16_t*)(ws + OFF_F))
#define ACT ((bf16_t*)(ws + OFF_BIG))
#define GATES ((bf16_t*)(ws + OFF_F))
#define DAQKV ((bf16_t*)(ws + OFF_BIG))
#define CBUF ((bf16_t*)(ws + OFF_CBUF))
#define QMLA ((bf16_t*)(ws + OFF_QMLA))
#define KVMLA ((bf16_t*)(ws + OFF_FFN))
#define KR ((bf16_t*)(ws + OFF_KR))
#define YDA HN
#define YMLA (HN + (size_t)MROWS * 1024)
#define TMP ((bf16_t*)(ws + OFF_BIG))
#define MERGED ((bf16_t*)(ws + OFF_FFN))
#define RSQ ((float*)(ws + OFF_RSQ))
#define RSKV ((float*)(ws + OFF_RSKV))
#define CTL ((int*)(ws + OFF_CTL))
    const int gtid = blockIdx.x * 512 + threadIdx.x, gthreads = gridDim.x * 512;
#if USE_GRID_SYNC
    cg::grid_group grid = cg::this_grid();
    { volatile LAS unsigned* st = (volatile LAS unsigned*)(lds + 131072); if (threadIdx.x < 2) st[threadIdx.x] = 0u; __syncthreads(); }
    XcdBarrier bar = xcd_barrier_post((unsigned*)(ws + OFF_CTL + 16384), (volatile LAS unsigned*)(lds + 131072));
    if (p.ph_lo < 0) grid.sync();
#define SEAM(ph) do { if ((ph) + 1 < p.ph_hi) xcd_barrier(bar); } while (0)
#else
#define SEAM(ph) do { } while (0)
#endif
#ifndef PHMASK
#define PHMASK 0x1fff
#endif
#define IN(ph) (((PHMASK >> (ph)) & 1) && p.ph_lo <= (ph) && (ph) < p.ph_hi)
#define M_HN ((bf16_t*)(ws + OFF_M_HN))
#define M_ACT ((bf16_t*)(ws + OFF_M_ACT))
#define M_F ((float*)(ws + OFF_M_F))
#define M_C ((bf16_t*)(ws + OFF_M_C))
#define M_HN2 ((bf16_t*)(ws + OFF_M_HN2))
#define M_DAQKV ((bf16_t*)(ws + OFF_M_DAQKV))
#define M_KVMLA ((bf16_t*)(ws + OFF_M_KVMLA))
#define M_KR ((bf16_t*)(ws + OFF_M_KR))
    if (IN(0)) {
        for (int i = gtid; i < 2 * MROWS; i += gthreads) { if (i < MROWS) RSQ[i] = 0.f; else RSKV[i - MROWS] = 0.f; }
        if (gtid < 64) CTL[gtid] = 0;
        { u32x4* z = (u32x4*)((bf16_t*)(ws + OFF_WIN) + (size_t)8512 * 2048); for (int i = gtid; i < 192 * 2048 / 8; i += gthreads) z[i] = (u32x4){0u, 0u, 0u, 0u}; }
        for (int i = gtid; i < (48 * 3072 + 48 * 2048 + 48 * 64) / 8; i += gthreads) {
            u32x4* z = i < 48 * 3072 / 8 ? (u32x4*)(ws + OFF_M_DAQKV) + i : (i < (48 * 3072 + 48 * 2048) / 8 ? (u32x4*)(ws + OFF_M_KVMLA) + (i - 48 * 3072 / 8) : (u32x4*)(ws + OFF_M_KR) + (i - (48 * 3072 + 48 * 2048) / 8));
            *z = (u32x4){0u, 0u, 0u, 0u}; }
        norm_rows(p, true, nullptr, 0.f, nullptr, p.in[I_F1PRE]);
        norm_meta(p, nullptr, nullptr, p.in[I_F1PRE], M_HN);
        cvt_jobs<0, 9>(p, (LAS float*)lds);
        SEAM(0);
    }
    if (IN(1)) {
        { pg8::EpiAct E{ACT}; run_gemm(lds, HN, D, (const bf16_t*)(ws + OFF_FFN), D, 2 * FF, D, E); }
        __syncthreads();
        SKINNY_FOR(blk, FF / 64) {
            const int n0 = 64 * blk; const bf16_t* B0 = (const bf16_t*)(ws + OFF_FFN) + (size_t)(256 * (n0 >> 7) + (n0 & 127)) * D;
            skinny_block<2>(lds, M_HN, D, B0, B0 + (size_t)128 * D, D, D, [&](const f32x4 (&g)[4], const f32x4 (&u)[4], int n, int m0) {
#pragma unroll
                for (int c = 0; c < 4; ++c)
#pragma unroll
                    for (int r = 0; r < 4; ++r) M_ACT[(size_t)(m0 + r) * FF + n0 + 16 * c + n] = (bf16_t)(pkbf(g[c][r] * pg8::sigmoidf_(g[c][r]) * u[c][r], 0.f) & 0xffffu); });
        }
        SEAM(1);
    }
    if (IN(2)) {
        { pg8::EpiBf16 E{FB, D}; run_gemm(lds, ACT, FF, (const bf16_t*)(ws + OFF_WD), FF, D, FF, E); }
        __syncthreads();
        SKINNY_FOR(blk, D / 64) {
            const int n0 = 64 * blk; const bf16_t* B0 = (const bf16_t*)(ws + OFF_WD) + (size_t)n0 * FF;
            skinny_block<1>(lds, M_ACT, FF, B0, B0, FF, FF, [&](const f32x4 (&v)[4], const f32x4 (&)[4], int n, int m0) {
#pragma unroll
                for (int c = 0; c < 4; ++c)
#pragma unroll
                    for (int r = 0; r < 4; ++r) M_F[(size_t)(m0 + r) * D + n0 + 16 * c + n] = v[c][r]; });
        }
        SEAM(2);
    }
    if (IN(3)) { norm_rows(p, true, FB, 0.5f, p.in[I_F1POST], p.in[I_MIXPRE]); norm_meta(p, M_F, p.in[I_F1POST], p.in[I_MIXPRE], M_HN2); SEAM(3); }
    if (IN(4)) {
        { pg8::EpiInProj E{GATES, DAQKV, CBUF, p.in[I_BGATE], RSQ, RSKV}; run_gemm(lds, HN, D, (const bf16_t*)(ws + OFF_WIN), D, NIN, D, E); }
        __syncthreads();
        SKINNY_FOR(blk, 41) {
            const int nrow = blk < 32 ? 5120 + 64 * blk : (blk < 40 ? 7936 + 64 * (blk - 32) : 8448);
            const bf16_t* B0 = (const bf16_t*)(ws + OFF_WIN) + (size_t)nrow * D;
            bf16_t* dst = blk < 32 ? M_DAQKV + (size_t)48 * 3072 + (nrow - 4096) : M_C + (blk < 40 ? 768 + (nrow - 7936) : 1280);
            const int ldd = blk < 32 ? 3072 : CP;
            skinny_block<1>(lds, M_HN2, D, B0, B0, D, D, [&](const f32x4 (&v)[4], const f32x4 (&)[4], int n, int m0) {
#pragma unroll
                for (int c = 0; c < 4; ++c)
#pragma unroll
                    for (int r = 0; r < 4; ++r) dst[(size_t)(m0 + r) * ldd + 16 * c + n] = (bf16_t)(pkbf(v[c][r], 0.f) & 0xffffu); });
        }
        SEAM(4);
    }
    if (IN(5)) {
        { pg8::EpiRowScale E{QMLA, 1536, RSQ, 1.f / 768.f}; run_gemm(lds, CBUF, CP, (const bf16_t*)(ws + OFF_WUQ), 768, 1536, 768, E); }
        __syncthreads();
        { pg8::EpiRowScale E{KVMLA, 2048, RSKV, 1.f / 512.f}; run_gemm(lds, CBUF + 768, CP, (const bf16_t*)(ws + OFF_WUKV), 512, 2048, 512, E); }
        __syncthreads();
        {
            LAS float* rsl = (LAS float*)(lds + 98304); const int lane = threadIdx.x & 63, wid = threadIdx.x >> 6;
            for (int rr = 2 * wid; rr < 2 * wid + 2; ++rr) { const u32x4 w = *(const u32x4*)(M_C + (size_t)rr * CP + 768 + 8 * lane); float ss = 0.f;
#define SQ2(x) { const float lo_ = __uint_as_float((x) << 16), hi_ = __uint_as_float((x) & 0xffff0000u); ss += lo_ * lo_ + hi_ * hi_; }
                SQ2(w.x) SQ2(w.y) SQ2(w.z) SQ2(w.w)
#undef SQ2
                ss = wave_sum(ss); if (lane == 0) rsl[rr] = ss; }
            __syncthreads();
            SKINNY_FOR(blk, D / 64) {
                const int n0 = 64 * blk; const bf16_t* B0 = (const bf16_t*)(ws + OFF_WUKV) + (size_t)n0 * 512;
                skinny_block<1>(lds, M_C + 768, CP, B0, B0, 512, 512, [&](const f32x4 (&v)[4], const f32x4 (&)[4], int n, int m0) {
#pragma unroll
                    for (int r = 0; r < 4; ++r) { const float sc = __builtin_amdgcn_rsqf(rsl[m0 + r] * (1.f / 512.f) + RMS_EPS);
#pragma unroll
                        for (int c = 0; c < 4; ++c) M_KVMLA[(size_t)(48 + m0 + r) * 2048 + n0 + 16 * c + n] = (bf16_t)(pkbf(v[c][r] * sc, 0.f) & 0xffffu); } });
            }
        }
        rope_k_rows(p);
        SEAM(5);
    }
    if (IN(6)) {
        att::AttnArgs A{DAQKV, QMLA, KVMLA, KR, M_DAQKV, M_KVMLA, M_KR, YDA, YMLA, p.in[I_TABLE], p.in[I_SUBG], p.in[I_LQ1], p.in[I_LK1], p.in[I_LQ2], p.in[I_LK2], CTL + 0};
        if (threadIdx.x >= 256) __builtin_amdgcn_s_setprio(1);
        att::attn_phase(lds, A);
        __builtin_amdgcn_s_setprio(0);
        SEAM(6);
    }
    if (IN(7)) {
        { pg8::EpiGate<0> E{GATES, TMP, MERGED, p.in[I_BGATE]}; run_gemm(lds, YDA, 1024, (const bf16_t*)(ws + OFF_WBDA), 1024, D, 1024, E); }
        __syncthreads();
        { pg8::EpiGate<1> E{GATES, TMP, MERGED, p.in[I_BGATE]}; run_gemm(lds, YMLA, 1024, (const bf16_t*)(ws + OFF_WBMLA), 1024, D, 1024, E); }
        SEAM(7);
    }
    if (IN(8)) { pg8::EpiBf16 E{FB, D}; run_gemm(lds, MERGED, D, (const bf16_t*)(ws + OFF_WOUT), D, D, D, E); SEAM(8); }
    if (IN(9)) { norm_rows(p, false, FB, 1.0f, p.in[I_MIXPOST], p.in[I_F2PRE]); cvt_jobs<9, 12>(p, (LAS float*)lds); SEAM(9); }
    if (IN(10)) { pg8::EpiAct E{ACT}; run_gemm(lds, HN, D, (const bf16_t*)(ws + OFF_FFN), D, 2 * FF, D, E); SEAM(10); }
    if (IN(11)) { pg8::EpiBf16 E{FB, D}; run_gemm(lds, ACT, FF, (const bf16_t*)(ws + OFF_WD), FF, D, FF, E); SEAM(11); }
    if (IN(12)) { norm_rows(p, false, FB, 0.5f, p.in[I_F2POST], nullptr); }
}


#ifdef DBG_STOP
__global__ void dbg_dump(const unsigned short* src, float* out, size_t n) {
    for (size_t i = (size_t)blockIdx.x * 256 + threadIdx.x; i < n; i += (size_t)gridDim.x * 256) out[i] = __uint_as_float((unsigned)src[i] << 16);
}
#endif
extern "C" void kernel_launch(void* const* d_in, const int* in_sizes, int n_in, void* d_out, int out_size, void* d_ws, size_t ws_size, hipStream_t stream) {
    static int grid = 0;
    if (grid == 0) {
        if (n_in != 29 || ws_size < WS_NEED || out_size != NBATCH * SEQ * D) { fprintf(stderr, "kernel_launch: unexpected problem (n_in %d, ws %zu need %zu, out %d)\n", n_in, ws_size, (size_t)WS_NEED, out_size); grid = -1; return; }
        int dev = 0, cus = 0, per_cu = 0;
        hipGetDevice(&dev); hipDeviceGetAttribute(&cus, hipDeviceAttributeMultiprocessorCount, dev);
        if (hipFuncSetAttribute((const void*)fwd_kernel, hipFuncAttributeMaxDynamicSharedMemorySize, LDS_BYTES) != hipSuccess) { fprintf(stderr, "hipFuncSetAttribute failed\n"); grid = -1; return; }
        if (hipOccupancyMaxActiveBlocksPerMultiprocessor(&per_cu, (const void*)fwd_kernel, 512, LDS_BYTES) != hipSuccess || per_cu < 1) { fprintf(stderr, "occupancy query: %d\n", per_cu); per_cu = 1; }
        (void)hipGetLastError();
        grid = cus * 1;
    }
    if (grid < 0) return;
    Params p{};
    for (int i = 0; i < 29; ++i) p.in[i] = (const float*)d_in[i];
    p.out = (float*)d_out; p.ws = (unsigned char*)d_ws;
#if USE_GRID_SYNC
#ifndef CUTS
#define CUTS {0, NPHASE}
#endif
    const int cuts[] = CUTS;
    for (int li = 0; li + 1 < (int)(sizeof(cuts) / sizeof(int)); ++li) {
        p.ph_lo = cuts[li]; p.ph_hi = cuts[li + 1];
        if (hipMemsetAsync((char*)d_ws + OFF_CTL + 16384, 0, 16384, stream) != hipSuccess) { fprintf(stderr, "memset failed\n"); return; }
        void* args[] = {&p};
        hipError_t e = hipLaunchCooperativeKernel((const void*)fwd_kernel, dim3(grid), dim3(512), args, LDS_BYTES, stream);
        if (e != hipSuccess) fprintf(stderr, "cooperative launch failed: %s (grid %d)\n", hipGetErrorString(e), grid);
    }
#else
#ifdef DBG_STOP
    for (int ph = 0; ph <= DBG_STOP; ++ph) { p.ph_lo = ph; p.ph_hi = ph + 1; hipLaunchKernelGGL(fwd_kernel, dim3(grid), dim3(512), LDS_BYTES, stream, p); }
#ifdef DBG_DUMP_OFF
    hipLaunchKernelGGL(dbg_dump, dim3(2048), dim3(256), 0, stream, (const unsigned short*)((unsigned char*)d_ws + (size_t)(DBG_DUMP_OFF)), (float*)d_out, (size_t)NBATCH * SEQ * D);
#endif
#else
    for (int ph = 0; ph < NPHASE; ++ph) { p.ph_lo = ph; p.ph_hi = ph + 1; hipLaunchKernelGGL(fwd_kernel, dim3(grid), dim3(512), LDS_BYTES, stream, p); }
#endif
#endif
}
```
